# Optimizing an MI355X kernel written in HIP

```python
import jax, jax.numpy as jnp
from jax import lax
import numpy as np

D_MODEL = 2048
BATCH = 2
SEQ = 4096
DEPTH = 1

CHUNK = 64
N_MEM = 256
EPS = 1e-6
GLA_HEADS = 4
GLA_DK = D_MODEL // 16
GLA_DV = D_MODEL // 8
GLA_LOWRANK = 16
GLA_GATE_NORMALIZER = 16.0
GLA_WIDTH = GLA_HEADS * GLA_DV
HGRN_HEADS = 8
HGRN_DH = D_MODEL // 16
HGRN_WIDTH = HGRN_HEADS * HGRN_DH
MIX_WIDTH = GLA_WIDTH + HGRN_WIDTH
IN_SPLITS = (GLA_HEADS * GLA_DK, GLA_HEADS * GLA_DK, GLA_WIDTH, GLA_WIDTH, GLA_LOWRANK,
             HGRN_WIDTH, HGRN_WIDTH, HGRN_WIDTH, HGRN_WIDTH)
IN_WIDTH = 512 + 512 + 1024 + 1024 + 16 + 4 * 1024
XA_HEADS = 4
XA_DH = D_MODEL // XA_HEADS
N_GROUPS = 4
EXPERTS_PER_GROUP = 8
N_EXPERTS = N_GROUPS * EXPERTS_PER_GROUP
TOP_K = 2
D_EXPERT = D_MODEL // 2
EXPERT_BLOCK = 128

kernel_name = "hybrid_gla_hgrn2_memxattn_hmoe"


def rmsnorm(x, g):
    xf = x.astype(jnp.float32)
    y = xf * lax.rsqrt(jnp.mean(xf * xf, axis=-1, keepdims=True) + EPS) * g.astype(jnp.float32)
    return y.astype(x.dtype)


def to_chunks(t, n_heads):
    B, T, _ = t.shape
    return t.reshape(B, T // CHUNK, CHUNK, n_heads, -1).transpose(1, 0, 3, 2, 4).astype(jnp.float32)


def from_chunks(t):
    N, B, H, C, d = t.shape
    return t.transpose(1, 0, 3, 2, 4).reshape(B, N * C, H, d)


def chunk_gated_linear_attention(q, k, v, log_a, n_heads, scale):
    qc = to_chunks(q, n_heads) * scale
    kc = to_chunks(k, n_heads)
    vc = to_chunks(v, n_heads)
    bc = jnp.cumsum(to_chunks(log_a, n_heads), axis=3)
    causal = jnp.tril(jnp.ones((CHUNK, CHUNK), dtype=bool))

    def step(S, inp):
        q_, k_, v_, b_ = inp
        rel = b_[:, :, :, None, :] - b_[:, :, None, :, :]
        decay = jnp.exp(jnp.where(causal[:, :, None], rel, -jnp.inf))
        A = jnp.einsum('bhid,bhjd,bhijd->bhij', q_, k_, decay)
        b_last = b_[:, :, -1:, :]
        o = (jnp.einsum('bhij,bhjv->bhiv', A, v_)
             + jnp.einsum('bhid,bhdv->bhiv', q_ * jnp.exp(b_), S))
        S = (jnp.exp(b_last[:, :, 0, :])[..., None] * S
             + jnp.einsum('bhjd,bhjv->bhdv', k_ * jnp.exp(b_last - b_), v_))
        return S, o

    B = q.shape[0]
    S0 = jnp.zeros((B, n_heads, qc.shape[-1], vc.shape[-1]), jnp.float32)
    _, o = lax.scan(step, S0, (qc, kc, vc, bc))
    return from_chunks(o)


def hybrid_mixer(h, w_in, w_alpha_up, b_alpha, gla_norm_g, lb, hgrn_norm_g, w_out):
    B, T, _ = h.shape
    f32 = jnp.float32
    proj = h @ w_in
    offsets = [int(o) for o in np.cumsum(IN_SPLITS)[:-1]]
    gq, gk, gv, gg, g_lr, hq, hf, hi, hg = jnp.split(proj, offsets, axis=-1)

    log_alpha = jax.nn.log_sigmoid((g_lr @ w_alpha_up + b_alpha).astype(f32)) / GLA_GATE_NORMALIZER
    o_gla = chunk_gated_linear_attention(gq, gk, gv, log_alpha, GLA_HEADS, GLA_DK ** -0.5)
    o_gla = rmsnorm(o_gla, gla_norm_g) * jax.nn.silu(gg.reshape(B, T, GLA_HEADS, GLA_DV).astype(f32))

    z = hf.astype(f32)
    log_f = jnp.logaddexp(jnp.log(lb), jnp.log1p(-lb) + jax.nn.log_sigmoid(z))
    k_h = (1.0 - lb) * jax.nn.sigmoid(-z)
    o_h = chunk_gated_linear_attention(jax.nn.silu(hq.astype(f32)), k_h, hi, log_f, HGRN_HEADS, 1.0)
    o_h = rmsnorm(o_h, hgrn_norm_g) * jax.nn.silu(hg.reshape(B, T, HGRN_HEADS, HGRN_DH).astype(f32))

    o = jnp.concatenate([o_gla.reshape(B, T, GLA_WIDTH), o_h.reshape(B, T, HGRN_WIDTH)], axis=-1)
    return o.astype(h.dtype) @ w_out


def memory_cross_attention(h, mem_n, w_q, w_kv, w_o):
    B, T, D = h.shape
    M = mem_n.shape[1]
    q = (h @ w_q).reshape(B, T, XA_HEADS, XA_DH)
    k, v = jnp.split(mem_n @ w_kv, 2, axis=-1)
    k = k.reshape(B, M, XA_HEADS, XA_DH)
    v = v.reshape(B, M, XA_HEADS, XA_DH)
    s = jnp.einsum('bqhd,bkhd->bhqk', q, k).astype(jnp.float32) * (XA_DH ** -0.5)
    p = jax.nn.softmax(s, axis=-1).astype(v.dtype)
    o = jnp.einsum('bhqk,bkhd->bqhd', p, v).reshape(B, T, D)
    return o @ w_o


def grouped_expert_mlp(xt, expert_idx, w_gate, w_up, w_down):
    M, K = expert_idx.shape
    D = xt.shape[-1]
    A = M * K
    flat_e = expert_idx.reshape(A)
    order = jnp.argsort(flat_e)
    sorted_e = flat_e[order]
    counts = jnp.bincount(flat_e, length=N_EXPERTS)
    padded = ((counts + EXPERT_BLOCK - 1) // EXPERT_BLOCK) * EXPERT_BLOCK
    pad_end = jnp.cumsum(padded)
    pad_start = pad_end - padded
    start = jnp.cumsum(counts) - counts
    dest = pad_start[sorted_e] + (jnp.arange(A) - start[sorted_e])
    n_rows = A + N_EXPERTS * EXPERT_BLOCK
    n_blocks = n_rows // EXPERT_BLOCK
    buf = jnp.zeros((n_rows, D), xt.dtype).at[dest].set(xt[order // K])
    block_e = jnp.minimum(jnp.searchsorted(pad_end, jnp.arange(n_blocks) * EXPERT_BLOCK, side='right'),
                          N_EXPERTS - 1)

    def block_fn(args):
        xb, e = args
        hb = jax.nn.silu(xb @ w_gate[e]) * (xb @ w_up[e])
        return hb @ w_down[e]

    yb = lax.map(block_fn, (buf.reshape(n_blocks, EXPERT_BLOCK, D), block_e)).reshape(n_rows, D)
    y = jnp.zeros((A, D), yb.dtype).at[order].set(yb[dest])
    return y.reshape(M, K, D)


def hierarchical_moe(h, w_rg, b_rg, w_re, b_re, w_gate, w_up, w_down):
    B, T, D = h.shape
    xt = h.reshape(B * T, D)
    g_prob = jax.nn.softmax((xt @ w_rg).astype(jnp.float32) + b_rg.astype(jnp.float32), axis=-1)
    p_group, group = lax.top_k(g_prob, 1)
    e_logits = ((xt @ w_re).astype(jnp.float32) + b_re.astype(jnp.float32)).reshape(-1, N_GROUPS, EXPERTS_PER_GROUP)
    e_logits = jnp.take_along_axis(e_logits, group[:, :, None], axis=1)[:, 0]
    top_val, top_idx = lax.top_k(e_logits, TOP_K)
    gate = jax.nn.softmax(top_val, axis=-1) * p_group
    expert_idx = group * EXPERTS_PER_GROUP + top_idx
    y = grouped_expert_mlp(xt, expert_idx, w_gate, w_up, w_down)
    out = jnp.einsum('mk,mkd->md', gate.astype(y.dtype), y)
    return out.reshape(B, T, D)


def setup_inputs(seed: int = 0) -> dict:
    key = jax.random.key(seed)
    ks = jax.random.split(key, 32)
    f32 = jnp.float32
    D, L = D_MODEL, DEPTH

    def nrm(k, shape, scale):
        return jax.random.normal(k, shape, f32) * scale

    def gain(k, shape):
        return 1.0 + 0.02 * jax.random.normal(k, shape, f32)

    return {
        "x": nrm(ks[0], (BATCH, SEQ, D), 1.0),
        "mem": nrm(ks[1], (BATCH, N_MEM, D), 1.0),
        "norm_mix_g": gain(ks[2], (L, D)),
        "w_in": nrm(ks[3], (L, D, IN_WIDTH), D ** -0.5),
        "w_gla_alpha_up": nrm(ks[4], (L, GLA_LOWRANK, GLA_HEADS * GLA_DK), GLA_LOWRANK ** -0.5),
        "b_gla_alpha": nrm(ks[5], (L, GLA_HEADS * GLA_DK), 0.1),
        "gla_out_norm_g": gain(ks[6], (L, GLA_DV)),
        "hgrn_lb_logits": nrm(ks[7], (L + 1, HGRN_WIDTH), 0.5),
        "hgrn_out_norm_g": gain(ks[8], (L, HGRN_DH)),
        "w_mix_out": nrm(ks[9], (L, MIX_WIDTH, D), MIX_WIDTH ** -0.5),
        "norm_xattn_g": gain(ks[10], (L, D)),
        "norm_mem_g": gain(ks[11], (L, D)),
        "w_xattn_q": nrm(ks[12], (L, D, D), D ** -0.5),
        "w_xattn_kv": nrm(ks[13], (L, D, 2 * D), D ** -0.5),
        "w_xattn_out": nrm(ks[14], (L, D, D), D ** -0.5),
        "norm_ffn_g": gain(ks[15], (L, D)),
        "w_router_group": nrm(ks[16], (L, D, N_GROUPS), D ** -0.5),
        "b_router_group": nrm(ks[17], (L, N_GROUPS), 0.01),
        "w_router_expert": nrm(ks[18], (L, D, N_EXPERTS), D ** -0.5),
        "b_router_expert": nrm(ks[19], (L, N_EXPERTS), 0.01),
        "w_expert_gate": nrm(ks[20], (L, N_EXPERTS, D, D_EXPERT), D ** -0.5),
        "w_expert_up": nrm(ks[21], (L, N_EXPERTS, D, D_EXPERT), D ** -0.5),
        "w_expert_down": nrm(ks[22], (L, N_EXPERTS, D_EXPERT, D), D_EXPERT ** -0.5),
        "norm_final_g": gain(ks[23], (D,)),
    }


def reference(x, mem, norm_mix_g, w_in, w_gla_alpha_up, b_gla_alpha, gla_out_norm_g, hgrn_lb_logits,
              hgrn_out_norm_g, w_mix_out, norm_xattn_g, norm_mem_g, w_xattn_q, w_xattn_kv, w_xattn_out,
              norm_ffn_g, w_router_group, b_router_group, w_router_expert, b_router_expert,
              w_expert_gate, w_expert_up, w_expert_down, norm_final_g):
    lb_all = jnp.cumsum(jax.nn.softmax(hgrn_lb_logits.astype(jnp.float32), axis=0), axis=0)
    h = x
    for l in range(DEPTH):
        a = rmsnorm(h, norm_mix_g[l])
        h = h + hybrid_mixer(a, w_in[l], w_gla_alpha_up[l], b_gla_alpha[l], gla_out_norm_g[l],
                             lb_all[l], hgrn_out_norm_g[l], w_mix_out[l])
        a = rmsnorm(h, norm_xattn_g[l])
        h = h + memory_cross_attention(a, rmsnorm(mem, norm_mem_g[l]), w_xattn_q[l], w_xattn_kv[l], w_xattn_out[l])
        a = rmsnorm(h, norm_ffn_g[l])
        h = h + hierarchical_moe(a, w_router_group[l], b_router_group[l], w_router_expert[l], b_router_expert[l],
                                 w_expert_gate[l], w_expert_up[l], w_expert_down[l])
    return rmsnorm(h, norm_final_g)
```

```cpp
#include <hip/hip_runtime.h>
#include <cstdio>
#include <cstdint>

#ifndef MK_ONE_LAUNCH
#define MK_ONE_LAUNCH 1
#endif

#define GAS __attribute__((address_space(1)))
#define LAS __attribute__((address_space(3)))
typedef unsigned short bf16;
typedef unsigned v4u __attribute__((ext_vector_type(4)));
typedef unsigned v2u __attribute__((ext_vector_type(2)));
typedef float f32x4 __attribute__((ext_vector_type(4)));
typedef float f32x2 __attribute__((ext_vector_type(2)));
typedef short bf16x8 __attribute__((ext_vector_type(8)));
typedef GAS unsigned gu32;
typedef int v8i __attribute__((ext_vector_type(8)));
typedef int v4i __attribute__((ext_vector_type(4)));

constexpr int DM = 2048, MTOK = 8192, SEQ = 4096, MEMR = 512, NPROJ = 7680, INW = 7184;
constexpr int NEXP = 32;
constexpr float EPS = 1e-6f;
constexpr int C_GQ = 0, C_GK = 512, C_GV = 1024, C_GG = 2048, C_GA = 3072, C_HQ = 3584, C_HK = 4608, C_HV = 5632, C_HG = 6656;

constexpr size_t MiB = 1ull << 20;
constexpr size_t WS_CTL = 0, CTL_ZERO_BYTES = 128 * 1024;
constexpr size_t WS_WTIN = 1 * MiB;
constexpr size_t WS_WTOUT = 31 * MiB;
constexpr size_t WS_WQN = 39 * MiB;
constexpr size_t WS_WOT = 47 * MiB;
constexpr size_t WS_WTKV = 55 * MiB;
constexpr size_t WS_WRT = 71 * MiB;
constexpr size_t WS_EXP1 = 72 * MiB;
constexpr size_t WS_EXP2 = 328 * MiB;
constexpr size_t WS_A1B = 456 * MiB;
constexpr size_t WS_MEMN = 488 * MiB;
constexpr size_t WS_KV = 490 * MiB;
constexpr size_t WS_PB = 494 * MiB;
constexpr size_t WS_Y = WS_PB + 48 * MiB;
constexpr size_t WS_LA = 614 * MiB;
constexpr size_t WS_LF = 630 * MiB;
constexpr size_t WS_UT = 662 * MiB;
constexpr size_t WS_DB = 726 * MiB;
constexpr size_t WS_ON = 727 * MiB;
constexpr size_t WS_H1 = 759 * MiB;
constexpr size_t WS_H1B = 823 * MiB;
constexpr size_t WS_MT = 855 * MiB;
constexpr size_t WS_NT = 863 * MiB;
constexpr size_t WS_PBUF = 871 * MiB;
constexpr size_t WS_LIST = 887 * MiB;
constexpr size_t WS_GATEW = 888 * MiB;
constexpr size_t WS_HID = 889 * MiB;
constexpr size_t WS_END = 913 * MiB;
constexpr int CW_DEP = 26624;
constexpr int CW_TMO = 0, CW_BAR = 4096, CW_CNT = 8192, CW_SS1 = 16384, CW_MT = 24576;
static_assert((CW_MT + 16 * 96) * 4 <= (int)CTL_ZERO_BYTES, "ctl");

constexpr int LDS_BYTES = 163840;
constexpr int RING_BYTES = 131072;
constexpr int EPI_OFF = RING_BYTES;
constexpr int TBL_OFF = RING_BYTES + 8192;
constexpr int MISC_OFF = LDS_BYTES - 256;

#define LDS_WAIT() asm volatile("s_waitcnt lgkmcnt(0)" ::: "memory")
#define VM_WAIT() asm volatile("s_waitcnt vmcnt(0)" ::: "memory")
#define RLX_AGENT __ATOMIC_RELAXED, __HIP_MEMORY_SCOPE_AGENT
__device__ __forceinline__ float bf2f(unsigned v) { return __uint_as_float(v << 16); }
__device__ __forceinline__ unsigned f2bf(float f) { unsigned u = __float_as_uint(f); return (u + 0x7fffu + ((u >> 16) & 1u)) >> 16; }
__device__ __forceinline__ unsigned pk2(float lo, float hi) { return f2bf(lo) | (f2bf(hi) << 16); }
__device__ __forceinline__ float wave_sum(float v) {
#pragma unroll
    for (int o = 1; o < 64; o <<= 1) v += __shfl_xor(v, o);
    return v;
}
__device__ __forceinline__ float sigmoidf_(float x) { return 1.f / (1.f + __expf(-x)); }
__device__ __forceinline__ float siluf_(float x) { return x / (1.f + __expf(-x)); }
__device__ __forceinline__ float logsigmoidf_(float x) { return fminf(x, 0.f) - __logf(1.f + __expf(-fabsf(x))); }

#define XB_TMO      128
#define XB_XCNT(j)  (256  + 64 * (j))
#define XB_XSUB(j)  (1280 + 64 * (j))
#define XB_XGEN(j)  (2304 + 64 * (j))
#define XB_TOP      3328
#define XB_TOPGEN   3392
#define XCD_BAR_WORDS 3456
#define XB_SPIN_CAP (1u << 18)
__device__ __forceinline__ unsigned xb_ld(unsigned* p)              { return __hip_atomic_load(p, __ATOMIC_RELAXED, __HIP_MEMORY_SCOPE_AGENT); }
__device__ __forceinline__ unsigned xb_add(unsigned* p, unsigned v) { return __hip_atomic_fetch_add(p, v, __ATOMIC_RELAXED, __HIP_MEMORY_SCOPE_AGENT); }
__device__ __forceinline__ unsigned xb_xcc_id() { return (unsigned)__builtin_amdgcn_s_getreg((3 << 11) | 20) & 0xFu; }
#define XB_SPIN(cond, bar) do { unsigned _sp = 0; while (cond) { __builtin_amdgcn_s_sleep(1); \
    if ((++_sp & 255u) == 0u) { if (xb_ld(&(bar)[XB_TMO])) break; if (_sp > XB_SPIN_CAP) { atomicAdd(&(bar)[XB_TMO], 1u); break; } } } } while (0)
struct XcdBarrier { unsigned* bar; unsigned x; volatile LAS unsigned* st; };
__device__ __forceinline__ XcdBarrier xcd_barrier_post(unsigned* bar, volatile LAS unsigned* st) {
    XcdBarrier b; b.bar = bar; b.x = xb_xcc_id(); b.st = st;
    if (threadIdx.x == 0) (void)xb_add(&bar[XB_XCNT(b.x)], 1u);
    return b;
}
__device__ __forceinline__ void xcd_barrier_complete(unsigned* bar, unsigned x, unsigned& nloc, unsigned& nx) {
    const unsigned G = gridDim.x * gridDim.y * gridDim.z;
    unsigned sum, cnt, mine, sp = 0u;
    for (;;) {
        sum = 0u; cnt = 0u; mine = 0u;
#pragma unroll
        for (unsigned j = 0; j < 16; ++j) { const unsigned c = xb_ld(&bar[XB_XCNT(j)]); sum += c; cnt += (c > 0u) ? 1u : 0u; mine = (j == x) ? c : mine; }
        if (sum == G) break;
        __builtin_amdgcn_s_sleep(1);
        if ((++sp & 255u) == 0u) { if (xb_ld(&bar[XB_TMO])) break; if (sp > XB_SPIN_CAP) { atomicAdd(&bar[XB_TMO], 1u); break; } }
    }
    nloc = mine > 0u ? mine : 1u; nx = cnt > 0u ? cnt : 1u;
}
__device__ __forceinline__ void xcd_barrier(const XcdBarrier& b) {
    asm volatile("s_waitcnt vmcnt(0)" ::: "memory");
    __syncthreads();
    if (threadIdx.x == 0) {
        unsigned* bar = b.bar;
        __builtin_amdgcn_s_waitcnt(0);
        unsigned nloc = b.st[0], nx = b.st[1];
        if (nloc == 0u) { xcd_barrier_complete(bar, b.x, nloc, nx); b.st[0] = nloc; b.st[1] = nx; }
        const unsigned old = xb_add(&bar[XB_XSUB(b.x)], 1u);
        const unsigned gen = old / nloc;
        if (old + 1u == (gen + 1u) * nloc) {
            __builtin_amdgcn_fence(__ATOMIC_RELEASE, "agent");
            asm volatile("s_waitcnt vmcnt(0)" ::: "memory");
            const unsigned og = xb_add(&bar[XB_TOP], 1u);
            const unsigned tg = og / nx;
            if (og + 1u == (tg + 1u) * nx) xb_add(&bar[XB_TOPGEN], 1u);
            else XB_SPIN(xb_ld(&bar[XB_TOPGEN]) == tg, bar);
            __builtin_amdgcn_fence(__ATOMIC_ACQUIRE, "agent");
            xb_add(&bar[XB_XGEN(b.x)], 1u);
            asm volatile("s_waitcnt vmcnt(0)" ::: "memory");
        } else {
            XB_SPIN(xb_ld(&bar[XB_XGEN(b.x)]) == gen, bar);
            __builtin_amdgcn_fence(__ATOMIC_ACQUIRE, "agent");
            asm volatile("s_waitcnt vmcnt(0)" ::: "memory");
        }
    }
    __syncthreads();
}

struct Params { const float* in[24]; float* out; unsigned char* ws; int ph_lo, ph_hi; };
enum { I_X = 0, I_MEM, I_NMIXG, I_WIN, I_WAUP, I_BALPHA, I_GLAG, I_LBLOG, I_HGRNG, I_WMIXOUT, I_NXG, I_NMEMG, I_WQ, I_WKV, I_WO, I_NFFNG, I_WRG, I_BRG, I_WRE, I_BRE,
       I_WEG, I_WEU, I_WED, I_NFING };

struct Ctx {
    Params p; LAS unsigned char* lds; int tid, lane, wave, vcu, G;
};
#define WSP(T, off) ((T*)(C.p.ws + (off)))
__device__ __forceinline__ void dep_publish(const Ctx& C, int stage, int mt) {
    asm volatile("s_waitcnt vmcnt(0)" ::: "memory"); __builtin_amdgcn_s_barrier();
    if (C.tid == 0) { __builtin_amdgcn_fence(__ATOMIC_RELEASE, "agent"); __hip_atomic_fetch_add(WSP(unsigned, WS_CTL) + CW_DEP + 16 * (32 * stage + mt), 1u, RLX_AGENT); }
}
__device__ __forceinline__ void dep_wait(const Ctx& C, int stage, int mt, unsigned target) {
    if (C.wave == 0) { unsigned* ctr = WSP(unsigned, WS_CTL) + CW_DEP + 16 * (32 * stage + mt); unsigned sp = 0;
        while ((unsigned)__builtin_amdgcn_readfirstlane((int)__hip_atomic_load(ctr, RLX_AGENT)) < target) { __builtin_amdgcn_s_sleep(2); if (++sp > (1u << 22)) { if (C.lane == 0) atomicAdd(WSP(unsigned, WS_CTL) + CW_TMO, 1u); break; } }
        __builtin_amdgcn_fence(__ATOMIC_ACQUIRE, "agent"); asm volatile("s_waitcnt vmcnt(0)" ::: "memory"); }
    asm volatile("" ::: "memory"); __builtin_amdgcn_s_barrier(); asm volatile("" ::: "memory");
}

__device__ __forceinline__ int rowmap(int kind, int n) {
    if (kind == 0) return n;
    if (kind == 1) return n < 3072 ? n : (n < 3088 ? -1 : (n < INW ? n + 496 : -1));
    if (kind == 2) return ((n >> 7) << 8) + (n & 127);
    return ((n >> 7) << 8) + 128 + (n & 127);
}
__device__ __forceinline__ void transpose_load(const float* W, int ldsrc, int nvalid, int k0, int n0, int lane, float (&tv)[32]) {
    const int nn = n0 + (lane & 31); const bool ok = nn < nvalid;
    const float* wp = W + (size_t)(k0 + (lane >> 5)) * ldsrc + (ok ? nn : 0);
#pragma unroll
    for (int i = 0; i < 32; ++i) tv[i] = __builtin_nontemporal_load(wp + (size_t)(2 * i) * ldsrc);
    if (!ok) {
#pragma unroll
        for (int i = 0; i < 32; ++i) tv[i] = 0.f; }
}
__device__ __forceinline__ void transpose_finish(const float (&tv)[32], int nvalid, int k0, int n0, bf16* WT, int lddst, int kind, LAS float* scr, int lane) {
#pragma unroll
    for (int i = 0; i < 32; ++i) { const int kk = 2 * i + (lane >> 5); scr[kk * 33 + (lane & 31)] = tv[i]; }
    LDS_WAIT(); asm volatile("" ::: "memory");
    const int c = lane & 7;
#pragma unroll
    for (int j = 0; j < 4; ++j) { const int n = (lane >> 3) + 8 * j; const LAS float* s = scr + (8 * c) * 33 + n;
        v4u o; o.x = pk2(s[0 * 33], s[1 * 33]); o.y = pk2(s[2 * 33], s[3 * 33]); o.z = pk2(s[4 * 33], s[5 * 33]); o.w = pk2(s[6 * 33], s[7 * 33]);
        const int r = (n0 + n < nvalid) ? rowmap(kind, n0 + n) : -1;
        if (r >= 0) *(v4u*)(WT + (size_t)r * lddst + k0 + 8 * c) = o; }
    LDS_WAIT(); asm volatile("" ::: "memory");
}
__device__ __forceinline__ void transpose_item(const float* W, int ldsrc, int nvalid, int k0, int n0, bf16* WT, int lddst, int kind, LAS float* scr, int lane) {
    float tv[32]; transpose_load(W, ldsrc, nvalid, k0, n0, lane, tv); transpose_finish(tv, nvalid, k0, n0, WT, lddst, kind, scr, lane);
}
__device__ __forceinline__ void rms_row_to_bf16(const float* xrow, const float* g, bf16* orow, int lane) {
    const f32x4* xr = (const f32x4*)xrow + lane; const f32x4* gr = (const f32x4*)g + lane;
    f32x4 v[8]; float s = 0.f;
#pragma unroll
    for (int j = 0; j < 8; ++j) { v[j] = __builtin_nontemporal_load(xr + 64 * j); s += (v[j].x * v[j].x + v[j].y * v[j].y) + (v[j].z * v[j].z + v[j].w * v[j].w); }
    const float rstd = rsqrtf(wave_sum(s) * (1.f / DM) + EPS);
    v2u* o8 = (v2u*)orow + lane;
#pragma unroll
    for (int j = 0; j < 8; ++j) { const f32x4 gg = gr[64 * j]; v2u w; w.x = pk2(v[j].x * rstd * gg.x, v[j].y * rstd * gg.y); w.y = pk2(v[j].z * rstd * gg.z, v[j].w * rstd * gg.w); o8[64 * j] = w; }
}
constexpr float WSCALE = 64.f, WSCALE_INV = 1.f / 64.f;
__device__ __forceinline__ unsigned pk4_fp8(float a, float b, float c, float d) {
    a = __builtin_amdgcn_fmed3f(a, -448.f, 448.f); b = __builtin_amdgcn_fmed3f(b, -448.f, 448.f); c = __builtin_amdgcn_fmed3f(c, -448.f, 448.f); d = __builtin_amdgcn_fmed3f(d, -448.f, 448.f);
    int r = __builtin_amdgcn_cvt_pk_fp8_f32(a, b, 0, false); r = __builtin_amdgcn_cvt_pk_fp8_f32(c, d, r, true); return (unsigned)r; }
struct XItem { const float* W; unsigned char* WT; int ld, k0, n0, ldd, kind; };
__device__ __forceinline__ XItem expert_item(const Ctx& C, int it) {
    XItem x; const int e = it / 1536, q = it % 1536, which = q >> 9, j = q & 511;
    if (which == 0) { x.W = C.p.in[I_WEG] + (size_t)e * 2048 * 1024; x.ld = 1024; x.k0 = 128 * (j / 32); x.n0 = 32 * (j % 32); x.WT = WSP(unsigned char, WS_EXP1) + (size_t)e * 2048 * 2048; x.ldd = 2048; x.kind = 2; }
    else if (which == 1) { x.W = C.p.in[I_WEU] + (size_t)e * 2048 * 1024; x.ld = 1024; x.k0 = 128 * (j / 32); x.n0 = 32 * (j % 32); x.WT = WSP(unsigned char, WS_EXP1) + (size_t)e * 2048 * 2048; x.ldd = 2048; x.kind = 3; }
    else { x.W = C.p.in[I_WED] + (size_t)e * 1024 * 2048; x.ld = 2048; x.k0 = 128 * (j / 64); x.n0 = 32 * (j % 64); x.WT = WSP(unsigned char, WS_EXP2) + (size_t)e * 2048 * 1024; x.ldd = 1024; x.kind = 0; }
    return x;
}
__device__ __forceinline__ void x_load(const XItem& x, int lane, float (&tv)[64]) {
    const float* wp = x.W + (size_t)(x.k0 + (lane >> 5)) * x.ld + x.n0 + (lane & 31);
#pragma unroll
    for (int i = 0; i < 64; ++i) tv[i] = __builtin_nontemporal_load(wp + (size_t)(2 * i) * x.ld);
}
__device__ __forceinline__ void x_finish(const float (&tv)[64], const XItem& x, LAS float* scr, int lane) {
#pragma unroll
    for (int i = 0; i < 64; ++i) { const int kk = 2 * i + (lane >> 5); scr[kk * 33 + (lane & 31)] = tv[i]; }
    LDS_WAIT(); asm volatile("" ::: "memory");
    const int c = lane & 7;
#pragma unroll
    for (int j = 0; j < 4; ++j) { const int n = (lane >> 3) + 8 * j; const LAS float* s = scr + (16 * c) * 33 + n;
        v4u o; o.x = pk4_fp8(s[0 * 33] * WSCALE, s[1 * 33] * WSCALE, s[2 * 33] * WSCALE, s[3 * 33] * WSCALE); o.y = pk4_fp8(s[4 * 33] * WSCALE, s[5 * 33] * WSCALE, s[6 * 33] * WSCALE, s[7 * 33] * WSCALE);
        o.z = pk4_fp8(s[8 * 33] * WSCALE, s[9 * 33] * WSCALE, s[10 * 33] * WSCALE, s[11 * 33] * WSCALE); o.w = pk4_fp8(s[12 * 33] * WSCALE, s[13 * 33] * WSCALE, s[14 * 33] * WSCALE, s[15 * 33] * WSCALE);
        __builtin_nontemporal_store(o, (v4u*)(x.WT + (size_t)rowmap(x.kind, x.n0 + n) * x.ldd + x.k0 + 16 * c)); }
    LDS_WAIT(); asm volatile("" ::: "memory");
}
constexpr int NX_TOTAL = 32 * 1536;
constexpr int NX_P1 = 32 * 8 * 12, NX_XPRE = 128 * 8 * 4, NX_SCORE = 128 * 8 * 14;
constexpr int NX_DEFER = NX_P1 + NX_XPRE + NX_SCORE;
__device__ __forceinline__ void convert_expert_items(const Ctx& C, int ibeg, int iend, int widx, int nw) {
    LAS float* scr = (LAS float*)(C.lds + C.wave * 16896);
    for (int it = ibeg + widx; it < iend; it += nw) { const XItem x = expert_item(C, it); float tv[64]; x_load(x, C.lane, tv); x_finish(tv, x, scr, C.lane); }
}
__device__ __forceinline__ void p0_prologue(const Ctx& C) {
    LAS float* scr = (LAS float*)(C.lds + C.wave * 16896);
    const int gw = C.vcu * 8 + C.wave, NGW = C.G * 8;
    const int gt = gw * 64 + C.lane, NGT = NGW * 64;
    constexpr int I0 = 32 * 225, I1 = 32 * 64, I2 = 32 * 64, I3 = 32 * 128;
    constexpr int NITEMS = I0 + I1 + I2 + I3;
    for (int it = gw; it < NITEMS; it += NGW) {
        int r = it;
        if (r < I0) { const int kb = r / 225, nb = r % 225; transpose_item(C.p.in[I_WIN], INW, INW, 64 * kb, 32 * nb, WSP(bf16, WS_WTIN), DM, 1, scr, C.lane); continue; } r -= I0;
        if (r < I1) { const int kb = r / 64, nb = r % 64; transpose_item(C.p.in[I_WMIXOUT], DM, DM, 64 * kb, 32 * nb, WSP(bf16, WS_WTOUT), DM, 0, scr, C.lane); continue; } r -= I1;
        if (r < I2) { const int kb = r / 64, nb = r % 64; transpose_item(C.p.in[I_WO], DM, DM, 64 * kb, 32 * nb, WSP(bf16, WS_WOT), DM, 0, scr, C.lane); continue; } r -= I2;
        { const int kb = r / 128, nb = r % 128; transpose_item(C.p.in[I_WKV], 4096, 4096, 64 * kb, 32 * nb, WSP(bf16, WS_WTKV), DM, 0, scr, C.lane); }
    }
    { const float* wq = C.p.in[I_WQ]; const float* g = C.p.in[I_NXG]; bf16* o = WSP(bf16, WS_WQN);
      for (int id = gt; id < DM * DM / 8; id += NGT) { const int k = id >> 8; const float gk = g[k]; const f32x4 a = __builtin_nontemporal_load((const f32x4*)(wq + (size_t)id * 8)), b = __builtin_nontemporal_load((const f32x4*)(wq + (size_t)id * 8 + 4));
          v4u w; w.x = pk2(a.x * gk, a.y * gk); w.y = pk2(a.z * gk, a.w * gk); w.z = pk2(b.x * gk, b.y * gk); w.w = pk2(b.z * gk, b.w * gk); *(v4u*)(o + (size_t)id * 8) = w; } }
    { const float* win = C.p.in[I_WIN]; const float* wup = C.p.in[I_WAUP]; bf16* o = WSP(bf16, WS_WTIN);
      for (int id = gt; id < 512 * 256; id += NGT) { const int c = id >> 8, k8 = id & 255; float up[16];
#pragma unroll
          for (int j = 0; j < 16; ++j) up[j] = wup[j * 512 + c];
          float r[8];
#pragma unroll
          for (int kk = 0; kk < 8; ++kk) { const float* wr = win + (size_t)(k8 * 8 + kk) * INW + 3072; float s = 0.f;
#pragma unroll
              for (int j = 0; j < 16; ++j) s += wr[j] * up[j];
              r[kk] = s; }
          v4u w; w.x = pk2(r[0], r[1]); w.y = pk2(r[2], r[3]); w.z = pk2(r[4], r[5]); w.w = pk2(r[6], r[7]);
          *(v4u*)(o + (size_t)(C_GA + c) * DM + k8 * 8) = w; } }
    { const float* wre = C.p.in[I_WRE]; const float* wrg = C.p.in[I_WRG]; const float* g = C.p.in[I_NFFNG]; float* o = WSP(float, WS_WRT);
      for (int id = gt; id < 48 * DM; id += NGT) { const int c = id >> 11, k = id & 2047; float v = 0.f;
          if (c < 32) v = g[k] * wre[k * 32 + c]; else if (c < 36) v = g[k] * wrg[k * 4 + (c - 32)];
          o[id] = v; } }
    for (int m = gw; m < MTOK + MEMR; m += NGW) {
        if (m < MTOK) rms_row_to_bf16(C.p.in[I_X] + (size_t)m * DM, C.p.in[I_NMIXG], WSP(bf16, WS_A1B) + (size_t)m * DM, C.lane);
        else rms_row_to_bf16(C.p.in[I_MEM] + (size_t)(m - MTOK) * DM, C.p.in[I_NMEMG], WSP(bf16, WS_MEMN) + (size_t)(m - MTOK) * DM, C.lane);
    }
}

struct Unit { const char* A; const char* B; bf16* Cb; unsigned lda2, ldb2; int ldc; int pm, pn, mode, e, mtl, cnt, mtg; };
enum { GK_PROJ = 1, GK_XPRE = 2, GK_OUT = 3, GK_SCORE = 4, GK_PV = 5, GK_MOE1 = 7, GK_MOE2 = 8 };

__device__ __forceinline__ void static_tile(int L, int nM, int nN, int& pm, int& pn) {
    const int nwg = nM * nN; int wgid = L;
    { const int q = nwg / 8, r = nwg % 8, xcd = wgid % 8, off = wgid / 8; wgid = (xcd < r ? xcd * (q + 1) : r * (q + 1) + (xcd - r) * q) + off; }
    const int nig = 2 * nN, gid = wgid / nig, fm = gid * 2, gsz = (nM - fm) < 2 ? (nM - fm) : 2;
    pm = fm + ((wgid % nig) % gsz); pn = (wgid % nig) / gsz;
}
__device__ __forceinline__ int gemm_K(int kind) { return kind == GK_XPRE ? 512 : ((kind == GK_PV || kind == GK_MOE2) ? 1024 : 2048); }

__device__ __forceinline__ bool unit_next(const Ctx& C, int kind, int i, Unit& u) {
    const int bx = blockIdx.x, G = C.G;
    u.e = 0; u.mtl = 0; u.cnt = 0; u.mtg = 0; u.mode = 0; u.Cb = nullptr; u.ldc = 0;
    if (kind == GK_PROJ) {
        const int L = i * G + bx; if (L >= 992) return false;
        u.lda2 = 4096; u.ldb2 = 4096;
        if (L < 960) { static_tile(L, 32, 30, u.pm, u.pn);
            u.A = (const char*)WSP(bf16, WS_A1B) + (size_t)u.pm * 256 * 4096; u.B = (const char*)WSP(bf16, WS_WTIN) + (size_t)u.pn * 256 * 4096;
            const int pn = u.pn; u.mode = (pn == 12 || pn == 13) ? 2 : (pn >= 18 && pn < 22) ? 3 : 0;
            u.Cb = WSP(bf16, WS_PB) + (size_t)u.pm * 256 * NPROJ + u.pn * 256; u.ldc = NPROJ; }
        else { const int j = L - 960; u.pm = j >> 4; u.pn = j & 15;
            u.A = (const char*)WSP(bf16, WS_MEMN) + (size_t)u.pm * 256 * 4096; u.B = (const char*)WSP(bf16, WS_WTKV) + (size_t)u.pn * 256 * 4096;
            u.mode = 0; u.Cb = WSP(bf16, WS_KV) + (size_t)u.pm * 256 * 4096 + u.pn * 256; u.ldc = 4096; }
        return true;
    }
    if (kind == GK_XPRE) {
        const int L = i * G + bx; if (L >= 128) return false;
        const int q = L & 63, b = q >> 5, h = (q >> 3) & 3, t = q & 7; u.pm = 0; u.pn = t;
        if (L < 64) {
            u.A = (const char*)WSP(bf16, WS_KV) + (size_t)(b * 256) * 8192 + h * 1024; u.lda2 = 8192;
            u.B = (const char*)WSP(bf16, WS_WQN) + (size_t)(t * 256) * 4096 + h * 1024; u.ldb2 = 4096;
            u.Cb = WSP(bf16, WS_MT) + (size_t)(b * 1024 + h * 256) * 2048 + t * 256; u.ldc = 2048;
        } else {
            u.A = (const char*)WSP(bf16, WS_WOT) + (size_t)(t * 256) * 4096 + h * 1024; u.lda2 = 4096;
            u.B = (const char*)WSP(bf16, WS_KV) + (size_t)(b * 256) * 8192 + 4096 + h * 1024; u.ldb2 = 8192;
            u.Cb = WSP(bf16, WS_NT) + (size_t)(b * 2048 + t * 256) * 1024 + h * 256; u.ldc = 1024;
        }
        return true;
    }
    if (kind == GK_OUT) {
        const int L = i * G + bx; if (L >= 256) return false;
        static_tile(L, 32, 8, u.pm, u.pn); u.lda2 = 4096; u.ldb2 = 4096;
        u.A = (const char*)WSP(bf16, WS_ON) + (size_t)u.pm * 256 * 4096; u.B = (const char*)WSP(bf16, WS_WTOUT) + (size_t)u.pn * 256 * 4096;
        return true;
    }
    if (kind == GK_SCORE) {
        const int L = i * G + bx; if (L >= 128) return false;
        static_tile(L, 32, 4, u.pm, u.pn); u.lda2 = 4096; u.ldb2 = 4096; dep_wait(C, 2, u.pm, 8u);
        u.A = (const char*)WSP(bf16, WS_H1B) + (size_t)u.pm * 256 * 4096; u.B = (const char*)WSP(bf16, WS_MT) + (size_t)((u.pm >> 4) * 1024 + u.pn * 256) * 4096;
        return true;
    }
    if (kind == GK_PV) {
        const int L = i * G + bx; if (L >= 256) return false;
        static_tile(L, 32, 8, u.pm, u.pn); u.lda2 = 2048; u.ldb2 = 2048; dep_wait(C, 3, u.pm, 4u);
        u.A = (const char*)WSP(bf16, WS_PBUF) + (size_t)u.pm * 256 * 2048; u.B = (const char*)WSP(bf16, WS_NT) + (size_t)((u.pm >> 4) * 2048 + u.pn * 256) * 2048;
        return true;
    }
    {
        const LAS int* ts = (const LAS int*)(C.lds + TBL_OFF); const LAS int* cn = ts + 40;
        const int L = i * G + (kind == GK_MOE2 ? G - 1 - C.vcu : C.vcu); const int TT8 = ts[32] * 8; if (L >= TT8) return false;
        int e = 0;
        for (int j = 1; j < 32; ++j) if (L >= ts[j] * 8) e = j;
        const int rem = L - ts[e] * 8, nte = ts[e + 1] - ts[e];
        u.e = __builtin_amdgcn_readfirstlane(e); u.pn = __builtin_amdgcn_readfirstlane(rem / nte); u.mtl = __builtin_amdgcn_readfirstlane(rem % nte);
        u.mtg = __builtin_amdgcn_readfirstlane(ts[e]) + u.mtl; u.cnt = __builtin_amdgcn_readfirstlane(cn[e]); u.pm = u.mtg;
        if (kind == GK_MOE1) { u.lda2 = 2048; u.ldb2 = 2048; u.A = (const char*)WSP(unsigned char, WS_A1B);
            u.B = (const char*)WSP(unsigned char, WS_EXP1) + (size_t)u.e * 2048 * 2048 + (size_t)u.pn * 256 * 2048; }
        else { u.lda2 = 1024; u.ldb2 = 1024; u.A = (const char*)WSP(unsigned char, WS_HID) + (size_t)u.mtg * 256 * 1024;
            if (C.wave == 0) { unsigned* ctr = WSP(unsigned, WS_CTL) + CW_MT + 16 * u.mtg; unsigned sp = 0;
                while ((unsigned)__builtin_amdgcn_readfirstlane((int)__hip_atomic_load(ctr, RLX_AGENT)) < 8u) { __builtin_amdgcn_s_sleep(2); if (++sp > (1u << 22)) { if (C.lane == 0) atomicAdd(WSP(unsigned, WS_CTL) + CW_TMO, 1u); break; } }
                __builtin_amdgcn_fence(__ATOMIC_ACQUIRE, "agent"); asm volatile("s_waitcnt vmcnt(0)" ::: "memory"); }
            asm volatile("" ::: "memory"); __builtin_amdgcn_s_barrier(); asm volatile("" ::: "memory");
            u.B = (const char*)WSP(unsigned char, WS_EXP2) + (size_t)u.e * 2048 * 1024 + (size_t)u.pn * 256 * 1024; }
        return true;
    }
}
__device__ __forceinline__ unsigned a_row_off(const Ctx& C, int kind, const Unit& u, int r) {
    if (kind == GK_MOE1) { const int slot = u.mtl * 256 + r; int tok = 0; if (slot < u.cnt) tok = WSP(int, WS_LIST)[u.e * 8192 + slot] >> 1; return (unsigned)tok * 2048u; }
    return (unsigned)r * u.lda2;
}

__device__ __forceinline__ unsigned cvt_pk_bf16(float lo, float hi) { unsigned r; asm volatile("v_cvt_pk_bf16_f32 %0, %1, %2" : "=v"(r) : "v"(lo), "v"(hi)); return r; }
__device__ __forceinline__ v4u pack8(const f32x4& a, const f32x4& b) { v4u w; w.x = cvt_pk_bf16(a[0], a[1]); w.y = cvt_pk_bf16(a[2], a[3]); w.z = cvt_pk_bf16(b[0], b[1]); w.w = cvt_pk_bf16(b[2], b[3]); return w; }

__device__ __forceinline__ void epilogue(const Ctx& C, int kind, const Unit& u, f32x4 (&acc)[2][2][4][2], int wr, int wc, int fr, int fq) {
    const int r0 = wr * 64 + fr;
    const int c0 = wc * 32 + fq * 8;
    if (kind == GK_PROJ) {
        if (u.mode == 0) {
#pragma unroll
            for (int ai = 0; ai < 2; ++ai)
#pragma unroll
                for (int m = 0; m < 4; ++m) { bf16* rowp = u.Cb + (size_t)(r0 + ai * 128 + m * 16) * u.ldc + c0;
#pragma unroll
                    for (int bj = 0; bj < 2; ++bj) *(v4u*)(rowp + bj * 128) = pack8(acc[ai][bj][m][0], acc[ai][bj][m][1]); }
        } else {
            const bool gla = u.mode == 2; float* G = gla ? WSP(float, WS_LA) : WSP(float, WS_LF); const int ldg = gla ? 512 : 1024; const float* ba = C.p.in[I_BALPHA];
#pragma unroll
            for (int bj = 0; bj < 2; ++bj) { const int cl = (u.pn - (gla ? 12 : 18)) * 256 + bj * 128 + c0;
                f32x4 b0 = {0.f, 0.f, 0.f, 0.f}, b1 = b0; if (gla) { b0 = *(const f32x4*)(ba + cl); b1 = *(const f32x4*)(ba + cl + 4); }
#pragma unroll
                for (int ai = 0; ai < 2; ++ai)
#pragma unroll
                    for (int m = 0; m < 4; ++m) { const int row = u.pm * 256 + r0 + ai * 128 + m * 16;
                        *(f32x4*)(G + (size_t)row * ldg + cl) = acc[ai][bj][m][0] + b0; *(f32x4*)(G + (size_t)row * ldg + cl + 4) = acc[ai][bj][m][1] + b1; } }
        }
        return;
    }
    if (kind == GK_XPRE) {
#pragma unroll
        for (int ai = 0; ai < 2; ++ai)
#pragma unroll
            for (int m = 0; m < 4; ++m) { bf16* rowp = u.Cb + (size_t)(r0 + ai * 128 + m * 16) * u.ldc + c0;
#pragma unroll
                for (int bj = 0; bj < 2; ++bj) *(v4u*)(rowp + bj * 128) = pack8(acc[ai][bj][m][0], acc[ai][bj][m][1]); }
        return;
    }
    if (kind == GK_OUT) {
        const float* X = C.p.in[I_X]; float* H1 = WSP(float, WS_H1); bf16* H1B = WSP(bf16, WS_H1B); float* ss1 = (float*)(WSP(unsigned, WS_CTL) + CW_SS1);
#pragma unroll
        for (int ai = 0; ai < 2; ++ai)
#pragma unroll
            for (int m = 0; m < 4; ++m) { const int row = u.pm * 256 + r0 + ai * 128 + m * 16; float s = 0.f;
#pragma unroll
                for (int bj = 0; bj < 2; ++bj) { const size_t off = (size_t)row * DM + u.pn * 256 + bj * 128 + c0;
                    const f32x4 h0 = *(const f32x4*)(X + off) + acc[ai][bj][m][0], h1 = *(const f32x4*)(X + off + 4) + acc[ai][bj][m][1];
                    *(f32x4*)(H1 + off) = h0; *(f32x4*)(H1 + off + 4) = h1; *(v4u*)(H1B + off) = pack8(h0, h1);
                    s += (h0[0] * h0[0] + h0[1] * h0[1]) + (h0[2] * h0[2] + h0[3] * h0[3]) + (h1[0] * h1[0] + h1[1] * h1[1]) + (h1[2] * h1[2] + h1[3] * h1[3]); }
                s += __shfl_xor(s, 16); s += __shfl_xor(s, 32);
                if (fq == 0) atomicAdd(ss1 + row, s); }
        return;
    }
    if (kind == GK_SCORE) {
        const float* ss1 = (const float*)(WSP(unsigned, WS_CTL) + CW_SS1); bf16* PB_ = WSP(bf16, WS_PBUF);
        LAS float* red = (LAS float*)(C.lds + EPI_OFF);
        float mx[2][4];
#pragma unroll
        for (int ai = 0; ai < 2; ++ai)
#pragma unroll
            for (int m = 0; m < 4; ++m) { const int rt = r0 + ai * 128 + m * 16; const int row = u.pm * 256 + rt;
                const float sc = rsqrtf(__hip_atomic_load(ss1 + row, RLX_AGENT) * (1.f / DM) + EPS) * 0.04419417382415922f; float mm = -3.0e38f;
#pragma unroll
                for (int bj = 0; bj < 2; ++bj)
#pragma unroll
                    for (int n = 0; n < 2; ++n) { acc[ai][bj][m][n] *= sc;
#pragma unroll
                        for (int j = 0; j < 4; ++j) mm = fmaxf(mm, acc[ai][bj][m][n][j]); }
                mm = fmaxf(mm, __shfl_xor(mm, 16)); mm = fmaxf(mm, __shfl_xor(mm, 32));
                if (fq == 0) red[rt * 4 + wc] = mm; }
        LDS_WAIT(); __syncthreads();
#pragma unroll
        for (int ai = 0; ai < 2; ++ai)
#pragma unroll
            for (int m = 0; m < 4; ++m) { const int rt = r0 + ai * 128 + m * 16; const f32x4 q = *(const LAS f32x4*)(red + rt * 4);
                const float mm = fmaxf(fmaxf(q[0], q[1]), fmaxf(q[2], q[3])); float s = 0.f;
#pragma unroll
                for (int bj = 0; bj < 2; ++bj)
#pragma unroll
                    for (int n = 0; n < 2; ++n)
#pragma unroll
                        for (int j = 0; j < 4; ++j) { const float e = __expf(acc[ai][bj][m][n][j] - mm); acc[ai][bj][m][n][j] = e; s += e; }
                s += __shfl_xor(s, 16); s += __shfl_xor(s, 32);
                if (fq == 0) red[1024 + rt * 4 + wc] = s; mx[ai][m] = 0.f; }
        LDS_WAIT(); __syncthreads();
#pragma unroll
        for (int ai = 0; ai < 2; ++ai)
#pragma unroll
            for (int m = 0; m < 4; ++m) { const int rt = r0 + ai * 128 + m * 16; const int row = u.pm * 256 + rt; const f32x4 q = *(const LAS f32x4*)(red + 1024 + rt * 4);
                const float inv = 1.f / ((q[0] + q[1]) + (q[2] + q[3]));
#pragma unroll
                for (int bj = 0; bj < 2; ++bj) { const f32x4 p0 = acc[ai][bj][m][0] * inv, p1 = acc[ai][bj][m][1] * inv;
                    *(v4u*)(PB_ + (size_t)row * 1024 + u.pn * 256 + bj * 128 + c0) = pack8(p0, p1); } }
        (void)mx;
        LDS_WAIT(); __syncthreads();
        return;
    }
    if (kind == GK_PV) {
        float* H1 = WSP(float, WS_H1);
#pragma unroll
        for (int ai = 0; ai < 2; ++ai)
#pragma unroll
            for (int m = 0; m < 4; ++m) { const int row = u.pm * 256 + r0 + ai * 128 + m * 16;
#pragma unroll
                for (int bj = 0; bj < 2; ++bj) { const size_t off = (size_t)row * DM + u.pn * 256 + bj * 128 + c0;
                    const f32x4 h0 = *(const f32x4*)(H1 + off) + acc[ai][bj][m][0], h1 = *(const f32x4*)(H1 + off + 4) + acc[ai][bj][m][1];
                    *(f32x4*)(H1 + off) = h0; *(f32x4*)(H1 + off + 4) = h1; } }
        return;
    }
    if (kind == GK_MOE1) {
        unsigned char* HID = WSP(unsigned char, WS_HID);
#pragma unroll
        for (int ai = 0; ai < 2; ++ai)
#pragma unroll
            for (int m = 0; m < 4; ++m) { const int rt = r0 + ai * 128 + m * 16; float h[8];
#pragma unroll
                for (int j = 0; j < 4; ++j) { h[j] = siluf_(acc[ai][0][m][0][j] * WSCALE_INV) * (acc[ai][1][m][0][j] * WSCALE_INV); h[4 + j] = siluf_(acc[ai][0][m][1][j] * WSCALE_INV) * (acc[ai][1][m][1][j] * WSCALE_INV); }
                v2u o; o.x = pk4_fp8(h[0], h[1], h[2], h[3]); o.y = pk4_fp8(h[4], h[5], h[6], h[7]);
                __hip_atomic_store((unsigned long long*)(HID + (size_t)(u.mtg * 256 + rt) * 1024 + u.pn * 128 + c0), ((unsigned long long)o.y << 32) | o.x, RLX_AGENT); }
        return;
    }
    {
        unsigned char* Y = WSP(unsigned char, WS_Y); const int* list = WSP(int, WS_LIST);
#pragma unroll
        for (int ai = 0; ai < 2; ++ai)
#pragma unroll
            for (int m = 0; m < 4; ++m) { const int rt = r0 + ai * 128 + m * 16; const int slot = u.mtl * 256 + rt;
                if (slot < u.cnt) { const int aid = list[u.e * 8192 + slot];
#pragma unroll
                    for (int bj = 0; bj < 2; ++bj) { const f32x4 a = acc[ai][bj][m][0] * WSCALE_INV, b = acc[ai][bj][m][1] * WSCALE_INV; v2u o; o.x = pk4_fp8(a[0], a[1], a[2], a[3]); o.y = pk4_fp8(b[0], b[1], b[2], b[3]);
                        *(v2u*)(Y + (size_t)aid * DM + u.pn * 256 + bj * 128 + c0) = o; } } }
    }
}

__device__ __forceinline__ void moe_tables(const Ctx& C) {
    LAS int* ts = (LAS int*)(C.lds + TBL_OFF); LAS int* cn = ts + 40;
    if (C.tid == 0) { const unsigned* cnt = WSP(unsigned, WS_CTL) + CW_CNT; int run = 0;
        for (int e = 0; e < 32; ++e) { const int c = (int)__hip_atomic_load(cnt + e * 64, RLX_AGENT); cn[e] = c; ts[e] = run; run += (c + 255) >> 8; }
        ts[32] = run; }
    LDS_WAIT(); __syncthreads();
}

constexpr int HTB = 128 * 64 * 2;
__device__ __forceinline__ int lds_byte(int r, int c) { const int st = (r >> 4) * 2 + (c >> 5), rr = r & 15, cc = c & 31, ob = rr * 64 + cc * 2; return st * 1024 + (ob ^ (((ob >> 9) & 1) << 5)); }
__device__ __forceinline__ void stage_rc(int b, int& R, int& Cc) { const int st = b / 1024, sb = b % 1024, swz = sb ^ (((sb >> 9) & 1) << 5); R = (st >> 1) * 16 + swz / 64; Cc = (st & 1) * 32 + (swz % 64) / 2; }
__device__ __forceinline__ int perm32(int rho) { const int n = rho >> 4, i = rho & 15; return 8 * (i >> 2) + 4 * n + (i & 3); }

__device__ __forceinline__ v8i mk8(bf16x8 lo, bf16x8 hi) { const v4i a = __builtin_bit_cast(v4i, lo), b = __builtin_bit_cast(v4i, hi); return __builtin_shufflevector(a, b, 0, 1, 2, 3, 4, 5, 6, 7); }
template <int KIND>
__device__ __forceinline__ void gemm_phase_fast(const Ctx& C) {
    constexpr bool GATHER = (KIND == GK_MOE1);
    constexpr bool MX = (KIND == GK_MOE1 || KIND == GK_MOE2);
    const int tid = C.tid, wid = C.wave, lane = C.lane, wr = wid >> 2, wc = wid & 3, fr = lane & 15, fq = lane >> 4;
    LAS unsigned char* lds = C.lds;
    if (KIND == GK_MOE1 || KIND == GK_MOE2) moe_tables(C);
    constexpr int K = (KIND == GK_XPRE) ? 512 : ((KIND == GK_PV || KIND == GK_MOE2) ? 1024 : 2048);
    constexpr int nt = MX ? K / 128 : K / 64;
    Unit cur, nxt; int ui = 0;
    if (!unit_next(C, KIND, 0, cur)) return;
    int Rs[2], Cs[2];
#pragma unroll
    for (int i = 0; i < 2; ++i) stage_rc(tid * 16 + i * 8192, Rs[i], Cs[i]);
    unsigned voffB[2], voffA[2];
#pragma unroll
    for (int i = 0; i < 2; ++i) { const int Rb = (Rs[i] & ~31) + perm32(Rs[i] & 31); voffB[i] = (unsigned)Rb * cur.ldb2 + (unsigned)Cs[i] * 2u; voffA[i] = (unsigned)Rs[i] * cur.lda2 + (unsigned)Cs[i] * 2u; }
    unsigned gA[2][2], gAn[2][2];
    if constexpr (GATHER) {
#pragma unroll
        for (int h = 0; h < 2; ++h)
#pragma unroll
            for (int i = 0; i < 2; ++i) { gA[h][i] = a_row_off(C, KIND, cur, h * 128 + Rs[i]) + (unsigned)Cs[i] * 2u; gAn[h][i] = gA[h][i]; }
    }
    const size_t hstepA = GATHER ? 0 : (size_t)128 * cur.lda2, hstepB = (size_t)128 * cur.ldb2;
    constexpr size_t kstep = 128;
    const unsigned ldsw = (unsigned)wid * 1024u;
    const int aoff = lds_byte(wr * 64 + fr, fq * 8), boff = lds_byte(wc * 32 + fr, fq * 8);
#define G_SA(b, h) (((b) * 2 + (h)) * HTB)
#define G_SB(b, h) ((4 + (b) * 2 + (h)) * HTB)
#define G_STAGE(bufoff, gbase, voff) do { _Pragma("unroll") for (int _i = 0; _i < 2; ++_i) \
        __builtin_amdgcn_global_load_lds((const unsigned*)((const char*)(gbase) + (voff)[_i]), (LAS unsigned*)(lds + (bufoff) + ldsw + _i * 8192), 16, 0, 0); } while (0)
#define G_STAGE_A(bufoff, ab, go, h, kb) do { if constexpr (GATHER) { G_STAGE(bufoff, (ab) + (kb), (go)[h]); } else { G_STAGE(bufoff, (ab) + (size_t)(h) * hstepA + (kb), voffA); } } while (0)
#define G_LDA(dst, b, h) do { if constexpr (MX) { _Pragma("unroll") for (int m = 0; m < 4; ++m) dst##8[m] = mk8(*(const LAS bf16x8*)(lds + G_SA(b, h) + aoff + m * 2048), *(const LAS bf16x8*)(lds + G_SA(b, h) + aoff + m * 2048 + 1024)); } \
        else { _Pragma("unroll") for (int m = 0; m < 4; ++m) _Pragma("unroll") for (int k = 0; k < 2; ++k) dst[m][k] = *(const LAS bf16x8*)(lds + G_SA(b, h) + aoff + m * 2048 + k * 1024); } } while (0)
#define G_LDB(dst, b, h) do { if constexpr (MX) { _Pragma("unroll") for (int n = 0; n < 2; ++n) dst##8[n] = mk8(*(const LAS bf16x8*)(lds + G_SB(b, h) + boff + n * 2048), *(const LAS bf16x8*)(lds + G_SB(b, h) + boff + n * 2048 + 1024)); } \
        else { _Pragma("unroll") for (int n = 0; n < 2; ++n) _Pragma("unroll") for (int k = 0; k < 2; ++k) dst[n][k] = *(const LAS bf16x8*)(lds + G_SB(b, h) + boff + n * 2048 + k * 1024); } } while (0)
#define G_MMA(ai, bj, At, Bt) do { __builtin_amdgcn_s_setprio(1); _Pragma("unroll") for (int m = 0; m < 4; ++m) _Pragma("unroll") for (int n = 0; n < 2; ++n) { \
        if constexpr (MX) { asm volatile("s_nop 1\n\tv_mfma_scale_f32_16x16x128_f8f6f4 %0, %1, %2, %0, %3, %3 op_sel_hi:[0,0,0]" : "+v"(acc[ai][bj][m][n]) : "v"(Bt##8[n]), "v"(At##8[m]), "v"(mxs)); } \
        else { _Pragma("unroll") for (int k = 0; k < 2; ++k) acc[ai][bj][m][n] = __builtin_amdgcn_mfma_f32_16x16x32_bf16(Bt[n][k], At[m][k], acc[ai][bj][m][n], 0, 0, 0); } } \
        __builtin_amdgcn_s_setprio(0); } while (0)
#define G_WAIT_V(n) asm volatile("s_waitcnt vmcnt(" #n ")" ::: "memory")
#define G_WAIT_L(n) asm volatile("s_waitcnt lgkmcnt(" #n ")" ::: "memory")
#define G_BAR __builtin_amdgcn_s_barrier()
#define G_SCHED __builtin_amdgcn_sched_barrier(0)
    f32x4 acc[2][2][4][2];
#pragma unroll
    for (int a = 0; a < 2; ++a)
#pragma unroll
        for (int b = 0; b < 2; ++b)
#pragma unroll
            for (int m = 0; m < 4; ++m)
#pragma unroll
                for (int n = 0; n < 2; ++n) acc[a][b][m][n] = (f32x4){0.f, 0.f, 0.f, 0.f};
    bf16x8 At[4][2], B0[2][2], B1[2][2];
    v8i At8[4], B08[2], B18[2];
    int mxs = 0x7f7f7f7f; asm volatile("" : "+v"(mxs));
    const char* cA = cur.A; const char* cB = cur.B;
    G_STAGE(G_SB(0, 0), cB, voffB); G_STAGE(G_SB(0, 1), cB + hstepB, voffB); G_STAGE_A(G_SA(0, 0), cA, gA, 0, 0); G_STAGE_A(G_SA(0, 1), cA, gA, 1, 0);
    if (wr == 1) G_BAR;
    G_WAIT_V(2); G_BAR;
    G_STAGE(G_SB(1, 0), cB + kstep, voffB); G_STAGE_A(G_SA(1, 0), cA, gA, 0, kstep); G_STAGE(G_SB(1, 1), cB + hstepB + kstep, voffB);
    G_WAIT_V(6); G_BAR;
    for (;;) {
        const bool has_next = unit_next(C, KIND, ui + 1, nxt);
        const char* nA = has_next ? nxt.A : cA; const char* nB = has_next ? nxt.B : cB;
        if constexpr (GATHER) { if (has_next) {
#pragma unroll
            for (int h = 0; h < 2; ++h)
#pragma unroll
                for (int i = 0; i < 2; ++i) gAn[h][i] = a_row_off(C, KIND, nxt, h * 128 + Rs[i]) + (unsigned)Cs[i] * 2u; } }
#pragma nounroll
        for (int t = 0; t < nt; t += 2) {
            const bool last = (t == nt - 2);
            const char* a2 = last ? nA : cA + (size_t)(t + 2) * kstep; const char* b2 = last ? nB : cB + (size_t)(t + 2) * kstep;
            unsigned g2[2][2];
            if constexpr (GATHER) {
#pragma unroll
                for (int h = 0; h < 2; ++h)
#pragma unroll
                    for (int i = 0; i < 2; ++i) g2[h][i] = last ? gAn[h][i] : gA[h][i]; }
            G_LDB(B0, 0, 0); G_LDB(B1, 0, 1); G_SCHED; G_LDA(At, 0, 0); G_STAGE_A(G_SA(1, 1), cA, gA, 1, (size_t)(t + 1) * kstep);
            G_WAIT_V(8); G_WAIT_L(0); G_BAR; G_MMA(0, 0, At, B0); G_MMA(0, 1, At, B1); G_BAR; G_SCHED;
            G_LDA(At, 0, 1); G_STAGE(G_SB(0, 0), b2, voffB); G_STAGE(G_SB(0, 1), b2 + hstepB, voffB); G_STAGE_A(G_SA(0, 0), a2, g2, 0, 0);
            G_WAIT_V(8); G_WAIT_L(0); G_BAR; G_MMA(1, 0, At, B0); G_MMA(1, 1, At, B1); G_BAR; G_SCHED;
            G_LDB(B0, 1, 0); G_LDB(B1, 1, 1); G_SCHED; G_LDA(At, 1, 0); G_STAGE_A(G_SA(0, 1), a2, g2, 1, 0);
            G_WAIT_V(8); G_WAIT_L(0); G_BAR; G_MMA(0, 0, At, B0); G_MMA(0, 1, At, B1); G_BAR; G_SCHED;
            G_LDA(At, 1, 1); G_STAGE(G_SB(1, 0), b2 + kstep, voffB); G_STAGE(G_SB(1, 1), b2 + kstep + hstepB, voffB); G_STAGE_A(G_SA(1, 0), a2, g2, 0, kstep);
            G_WAIT_V(8); G_WAIT_L(0); G_BAR; G_MMA(1, 0, At, B0); G_MMA(1, 1, At, B1); G_BAR; G_SCHED;
        }
        if (wr == 0) G_BAR;
        if constexpr (MX) asm volatile("s_nop 15\n\ts_nop 15" ::: "memory");
        { int te = threadIdx.x; asm volatile("" : "+v"(te));
          const int el = te & 63, ew = __builtin_amdgcn_readfirstlane(te >> 6); epilogue(C, KIND, cur, acc, ew >> 2, ew & 3, el & 15, el >> 4); }
        if constexpr (KIND == GK_MOE1) {
            G_WAIT_V(0); G_BAR;
            if (tid == 0) __hip_atomic_fetch_add(WSP(unsigned, WS_CTL) + CW_MT + 16 * cur.mtg, 1u, RLX_AGENT); }
        if constexpr (KIND == GK_OUT) dep_publish(C, 2, cur.pm);
        if constexpr (KIND == GK_SCORE) dep_publish(C, 3, cur.pm);
        if (!has_next) break;
#pragma unroll
        for (int a = 0; a < 2; ++a)
#pragma unroll
            for (int b = 0; b < 2; ++b)
#pragma unroll
                for (int m = 0; m < 4; ++m)
#pragma unroll
                    for (int n = 0; n < 2; ++n) acc[a][b][m][n] = (f32x4){0.f, 0.f, 0.f, 0.f};
        cur = nxt; cA = nA; cB = nB; ++ui;
        if constexpr (GATHER) {
#pragma unroll
            for (int h = 0; h < 2; ++h)
#pragma unroll
                for (int i = 0; i < 2; ++i) gA[h][i] = gAn[h][i]; }
        if (wr == 1) G_BAR;
    }
    G_WAIT_V(0);
    G_BAR;
#undef G_SA
#undef G_SB
#undef G_STAGE
#undef G_STAGE_A
#undef G_LDA
#undef G_LDB
#undef G_MMA
#undef G_WAIT_V
#undef G_WAIT_L
#undef G_BAR
#undef G_SCHED
}

__device__ __forceinline__ void la_phase_scan(const Ctx& C) {
    const int g = blockIdx.x * 512 + C.tid;
    bf16* base; const float* db; size_t cstride, dstride;
    if (g < 65536) { const int d4 = g & 31, v = (g >> 5) & 255, h = (g >> 13) & 3, b = g >> 15;
        base = WSP(bf16, WS_UT) + ((size_t)(b * 64 * 4 + h) * 256 + v) * 128 + d4 * 4; cstride = (size_t)4 * 256 * 128;
        db = WSP(float, WS_DB) + (size_t)(b * 64 * 4 + h) * 128 + d4 * 4; dstride = 4 * 128; }
    else { const int g2 = g - 65536; const int d4 = g2 & 31, v = (g2 >> 5) & 127, h = (g2 >> 12) & 7, b = g2 >> 15;
        base = WSP(bf16, WS_UT) + (size_t)128 * 4 * 256 * 128 + ((size_t)(b * 64 * 8 + h) * 128 + v) * 128 + d4 * 4; cstride = (size_t)8 * 128 * 128;
        db = WSP(float, WS_DB) + 128 * 4 * 128 + (size_t)(b * 64 * 8 + h) * 128 + d4 * 4; dstride = 8 * 128; }
    float S[4] = {0.f, 0.f, 0.f, 0.f};
    for (int c0 = 0; c0 < 64; c0 += 8) {
        v2u uu[8]; f32x4 dd[8];
#pragma unroll
        for (int j = 0; j < 8; ++j) { uu[j] = *(const v2u*)(base + (size_t)(c0 + j) * cstride); dd[j] = *(const f32x4*)(db + (size_t)(c0 + j) * dstride); }
#pragma unroll
        for (int j = 0; j < 8; ++j) { v2u o; o.x = pk2(S[0], S[1]); o.y = pk2(S[2], S[3]); *(v2u*)(base + (size_t)(c0 + j) * cstride) = o;
            S[0] = dd[j][0] * S[0] + bf2f(uu[j].x & 0xffffu); S[1] = dd[j][1] * S[1] + bf2f(uu[j].x >> 16);
            S[2] = dd[j][2] * S[2] + bf2f(uu[j].y & 0xffffu); S[3] = dd[j][3] * S[3] + bf2f(uu[j].y >> 16); }
    }
}
__device__ __forceinline__ bf16x8 ld_frag(const LAS unsigned char* base, int stride, int row0, int ks, int lane) {
    return *(const LAS bf16x8*)(base + (row0 + (lane & 15)) * stride + (32 * ks + 8 * (lane >> 4)) * 2);
}
template <int DV>
__device__ __forceinline__ void load_vT_regs(const Ctx& C, const bf16* vsrc  , v4u (&r)[DV / 64]) {
    const int lane = C.lane, tl = lane & 15, v8l = lane >> 4;
#pragma unroll
    for (int it = 0; it < DV / 64; ++it) { const int blk = C.wave * (DV / 64) + it; const int tb = blk & 3, vb = blk >> 2; const int t = tb * 16 + tl, v8 = vb * 4 + v8l;
        r[it] = *(const v4u*)(vsrc + (size_t)t * NPROJ + v8 * 8); }
}
template <int DV>
__device__ __forceinline__ void store_vT_regs(const Ctx& C, LAS unsigned char* VR, const v4u (&r)[DV / 64]) {
    const int lane = C.lane, tl = lane & 15, v8l = lane >> 4;
#pragma unroll
    for (int it = 0; it < DV / 64; ++it) { const int blk = C.wave * (DV / 64) + it; const int tb = blk & 3, vb = blk >> 2; const int t = tb * 16 + tl, v8 = vb * 4 + v8l;
        *(LAS v4u*)(VR + t * (DV * 2 + 16) + v8 * 16) = r[it]; }
}
typedef short v4s __attribute__((ext_vector_type(4)));
template <int DV>
__device__ __forceinline__ bf16x8 ld_frag_tr(const LAS unsigned char* VR, int v0, int ks, int lane) {
    const int g = lane >> 4, i = lane & 15, q = i >> 2, p = i & 3;
    const LAS unsigned char* a0 = VR + (32 * ks + 8 * g + q) * (DV * 2 + 16) + (v0 + 4 * p) * 2;
    const v4s lo = __builtin_amdgcn_ds_read_tr16_b64_v4i16((LAS v4s*)a0), hi = __builtin_amdgcn_ds_read_tr16_b64_v4i16((LAS v4s*)(a0 + 4 * (DV * 2 + 16)));
    return (bf16x8){lo[0], lo[1], lo[2], lo[3], hi[0], hi[1], hi[2], hi[3]};
}
template <int DV> struct PaRegs { v4u vr[DV / 64]; float gt[16]; unsigned qv[16], kv[16]; };
template <int DV, bool GLA>
__device__ __forceinline__ void pa_load(const Ctx& C, int bc, int h, PaRegs<DV>& R) {
    const int tid = C.tid, d = tid & 127, sg = tid >> 7; const int t0 = bc * 64;
    const bf16* PB = WSP(bf16, WS_PB);
    const float* gate = GLA ? WSP(float, WS_LA) : WSP(float, WS_LF); constexpr int ldg = GLA ? 512 : 1024;
    const int qcol = (GLA ? C_GQ : C_HQ) + h * 128, kcol = (GLA ? C_GK : C_HK) + h * 128, vcol = (GLA ? C_GV : C_HV) + h * DV;
    load_vT_regs<DV>(C, PB + (size_t)t0 * NPROJ + vcol, R.vr);
    const float* gp = gate + (size_t)(t0 + sg * 16) * ldg + h * 128 + d; const bf16* pq = PB + (size_t)(t0 + sg * 16) * NPROJ + qcol + d; const bf16* pk = PB + (size_t)(t0 + sg * 16) * NPROJ + kcol + d;
#pragma unroll
    for (int i = 0; i < 16; ++i) { R.gt[i] = __builtin_nontemporal_load(gp + (size_t)i * ldg); R.qv[i] = __builtin_nontemporal_load(pq + (size_t)i * NPROJ); if (GLA) R.kv[i] = __builtin_nontemporal_load(pk + (size_t)i * NPROJ); }
}
template <int DV, bool GLA>
__device__ __forceinline__ void pa_part1(const Ctx& C, int bc, int h, const PaRegs<DV>& R) {
    const int tid = C.tid, d = tid & 127, sg = tid >> 7;
    LAS unsigned char* kT = C.lds;
    LAS unsigned char* VT = C.lds + 18432;
    LAS float* seg = (LAS float*)(C.lds + 18432 + 36864);
    LAS float* Dl  = seg + 512;
    const int t0 = bc * 64;
    bf16* PB = WSP(bf16, WS_PB);
    const int qcol = (GLA ? C_GQ : C_HQ) + h * 128, kcol = (GLA ? C_GK : C_HK) + h * 128;
    constexpr float qscale = GLA ? 0.08838834764831845f : 1.0f;
    store_vT_regs<DV>(C, VT, R.vr);
    float gt[16], qf[16], kf[16];
    { float lb = 0.f; if (!GLA) { const float* lg = C.p.in[I_LBLOG]; lb = 1.f / (1.f + __expf(lg[1024 + h * 128 + d] - lg[h * 128 + d])); }
#pragma unroll
      for (int i = 0; i < 16; ++i) { const float q = bf2f(R.qv[i]);
          if (GLA) { gt[i] = logsigmoidf_(R.gt[i]) * 0.0625f; qf[i] = q; kf[i] = bf2f(R.kv[i]); }
          else { const float z = fminf(fmaxf(R.gt[i], -30.f), 30.f), ez = __expf(-z), sg = 1.f / (1.f + ez);
                 gt[i] = __logf(lb + (1.f - lb) * sg); kf[i] = (1.f - lb) * ez * sg; qf[i] = siluf_(q); } } }
    float run = 0.f;
#pragma unroll
    for (int i = 0; i < 16; ++i) run += gt[i];
    seg[sg * 128 + d] = run;
    LDS_WAIT(); __syncthreads();
    float b = 0.f;
    for (int s = 0; s < sg; ++s) b += seg[s * 128 + d];
    { bf16* pq = PB + (size_t)(t0 + sg * 16) * NPROJ + qcol + d; bf16* pk = PB + (size_t)(t0 + sg * 16) * NPROJ + kcol + d;
#pragma unroll
      for (int hh = 0; hh < 2; ++hh) { unsigned kk[8];
#pragma unroll
        for (int i = 0; i < 8; ++i) {
            b += gt[hh * 8 + i];
            const unsigned qt = f2bf(qf[hh * 8 + i] * qscale * __expf(b)), kt = f2bf(kf[hh * 8 + i] * __expf(-b));
            pq[(size_t)(hh * 8 + i) * NPROJ] = (bf16)qt; pk[(size_t)(hh * 8 + i) * NPROJ] = (bf16)kt; kk[i] = kt; }
        v4u w; w.x = kk[0] | (kk[1] << 16); w.y = kk[2] | (kk[3] << 16); w.z = kk[4] | (kk[5] << 16); w.w = kk[6] | (kk[7] << 16);
        *(LAS v4u*)(kT + d * 144 + (sg * 16 + hh * 8) * 2) = w; }
      if (sg == 3) { const float dd = __expf(b); Dl[d] = dd; (GLA ? WSP(float, WS_DB) + (size_t)(bc * 4 + h) * 128 : WSP(float, WS_DB) + 128 * 4 * 128 + (size_t)(bc * 8 + h) * 128)[d] = dd; } }
}
template <int DV, bool GLA>
__device__ __forceinline__ void pa_part2(const Ctx& C, int bc, int h) {
    const int lane = C.lane;
    LAS unsigned char* kT = C.lds; LAS unsigned char* VT = C.lds + 18432; LAS float* Dl = (LAS float*)(C.lds + 18432 + 36864) + 512;
    LDS_WAIT(); __syncthreads();
    { const int dt = C.wave; bf16* UT = GLA ? WSP(bf16, WS_UT) + (size_t)(bc * 4 + h) * 256 * 128 : WSP(bf16, WS_UT) + (size_t)128 * 4 * 256 * 128 + (size_t)(bc * 8 + h) * 128 * 128;
      const bf16x8 k0 = ld_frag(kT, 144, dt * 16, 0, lane), k1 = ld_frag(kT, 144, dt * 16, 1, lane);
      const f32x4 dd = *(const LAS f32x4*)(Dl + dt * 16 + 4 * (lane >> 4));
      for (int v4 = 0; v4 < DV / 64; ++v4) { bf16x8 f0[4], f1[4]; f32x4 acc[4];
#pragma unroll
          for (int j = 0; j < 4; ++j) { f0[j] = ld_frag_tr<DV>(VT, (v4 * 4 + j) * 16, 0, lane); f1[j] = ld_frag_tr<DV>(VT, (v4 * 4 + j) * 16, 1, lane); }
#pragma unroll
          for (int j = 0; j < 4; ++j) acc[j] = __builtin_amdgcn_mfma_f32_16x16x32_bf16(k0, f0[j], (f32x4){0.f, 0.f, 0.f, 0.f}, 0, 0, 0);
#pragma unroll
          for (int j = 0; j < 4; ++j) acc[j] = __builtin_amdgcn_mfma_f32_16x16x32_bf16(k1, f1[j], acc[j], 0, 0, 0);
#pragma unroll
          for (int j = 0; j < 4; ++j) { v2u o; o.x = pk2(acc[j][0] * dd[0], acc[j][1] * dd[1]); o.y = pk2(acc[j][2] * dd[2], acc[j][3] * dd[3]);
              *(v2u*)(UT + (size_t)((v4 * 4 + j) * 16 + (lane & 15)) * 128 + dt * 16 + 4 * (lane >> 4)) = o; } } }
    LDS_WAIT(); __syncthreads();
}
__device__ __forceinline__ void la2_phase_a(const Ctx& C) {
    const int w = blockIdx.x, bc = w >> 1, half = w & 1;
    PaRegs<256> g0, g1; PaRegs<128> h0, h1, h2, h3;
#define SB_ __builtin_amdgcn_sched_barrier(0)
    pa_load<256, true>(C, bc, half * 2 + 0, g0); SB_;
    pa_load<256, true>(C, bc, half * 2 + 1, g1); SB_; pa_part1<256, true>(C, bc, half * 2 + 0, g0); pa_part2<256, true>(C, bc, half * 2 + 0); SB_;
    pa_load<128, false>(C, bc, half * 4 + 0, h0); SB_; pa_part1<256, true>(C, bc, half * 2 + 1, g1); pa_part2<256, true>(C, bc, half * 2 + 1); SB_;
    pa_load<128, false>(C, bc, half * 4 + 1, h1); SB_; pa_part1<128, false>(C, bc, half * 4 + 0, h0); pa_part2<128, false>(C, bc, half * 4 + 0); SB_;
    pa_load<128, false>(C, bc, half * 4 + 2, h2); SB_; pa_part1<128, false>(C, bc, half * 4 + 1, h1); pa_part2<128, false>(C, bc, half * 4 + 1); SB_;
    pa_load<128, false>(C, bc, half * 4 + 3, h3); SB_; pa_part1<128, false>(C, bc, half * 4 + 2, h2); pa_part2<128, false>(C, bc, half * 4 + 2); SB_;
    pa_part1<128, false>(C, bc, half * 4 + 3, h3); pa_part2<128, false>(C, bc, half * 4 + 3);
#undef SB_
}
template <int DV> struct PcRegs { v4u qr[2], kr[2], sr[DV / 32], vr[DV / 64]; };
template <int DV, bool GLA>
__device__ __forceinline__ void pc_load(const Ctx& C, int bc, int h, PcRegs<DV>& R) {
    const int tid = C.tid; const int t0 = bc * 64; const bf16* PB = WSP(bf16, WS_PB);
    const int qcol = (GLA ? C_GQ : C_HQ) + h * 128, kcol = (GLA ? C_GK : C_HK) + h * 128, vcol = (GLA ? C_GV : C_HV) + h * DV;
    const bf16* ST = GLA ? WSP(bf16, WS_UT) + (size_t)(bc * 4 + h) * 256 * 128 : WSP(bf16, WS_UT) + (size_t)128 * 4 * 256 * 128 + (size_t)(bc * 8 + h) * 128 * 128;
#pragma unroll
    for (int it = 0; it < 2; ++it) { const int idx = tid + it * 512; const int t = idx >> 4, c8 = idx & 15;
        R.qr[it] = __builtin_nontemporal_load((const v4u*)(PB + (size_t)(t0 + t) * NPROJ + qcol + c8 * 8)); R.kr[it] = __builtin_nontemporal_load((const v4u*)(PB + (size_t)(t0 + t) * NPROJ + kcol + c8 * 8)); }
#pragma unroll
    for (int it = 0; it < DV / 32; ++it) { const int idx = tid + it * 512; const int v = idx >> 4, c8 = idx & 15; R.sr[it] = __builtin_nontemporal_load((const v4u*)(ST + (size_t)v * 128 + c8 * 8)); }
    load_vT_regs<DV>(C, PB + (size_t)t0 * NPROJ + vcol, R.vr);
}
template <int DV, bool GLA>
__device__ __forceinline__ void pc_part1(const Ctx& C, const PcRegs<DV>& R) {
    const int tid = C.tid;
    LAS unsigned char* qL = C.lds; LAS unsigned char* kL = C.lds + 17408; LAS unsigned char* VT = C.lds + 34816; LAS unsigned char* sL = C.lds + 34816 + 36864;
#pragma unroll
    for (int it = 0; it < 2; ++it) { const int idx = tid + it * 512; const int t = idx >> 4, c8 = idx & 15;
        *(LAS v4u*)(qL + t * 272 + c8 * 16) = R.qr[it]; *(LAS v4u*)(kL + t * 272 + c8 * 16) = R.kr[it]; }
#pragma unroll
    for (int it = 0; it < DV / 32; ++it) { const int idx = tid + it * 512; const int v = idx >> 4, c8 = idx & 15; *(LAS v4u*)(sL + v * 272 + c8 * 16) = R.sr[it]; }
    store_vT_regs<DV>(C, VT, R.vr);
}
template <int DV, bool GLA>
__device__ __forceinline__ void pc_part2(const Ctx& C, int bc, int h) {
    const int lane = C.lane, w = C.wave;
    LAS unsigned char* qL = C.lds;
    LAS unsigned char* kL = C.lds + 17408;
    LAS unsigned char* VT = C.lds + 34816;
    LAS unsigned char* sL = C.lds + 34816 + 36864;
    LAS unsigned char* AL = C.lds + 71680 + 69632;
    LAS float* red = (LAS float*)(C.lds + 141312 + 9216);
    const int t0 = bc * 64;
    const bf16* PB = WSP(bf16, WS_PB);
    const int gcol = (GLA ? C_GG : C_HG) + h * DV;
    LDS_WAIT(); __syncthreads();
    { const int it = w & 3, jt0 = (w >> 2) * 2; f32x4 a2[2] = {{0.f, 0.f, 0.f, 0.f}, {0.f, 0.f, 0.f, 0.f}};
      if (jt0 <= it) {
#pragma unroll
          for (int ks = 0; ks < 4; ++ks) { const bf16x8 qf = ld_frag(qL, 272, it * 16, ks, lane), k0 = ld_frag(kL, 272, jt0 * 16, ks, lane), k1 = ld_frag(kL, 272, jt0 * 16 + 16, ks, lane);
              a2[0] = __builtin_amdgcn_mfma_f32_16x16x32_bf16(k0, qf, a2[0], 0, 0, 0); a2[1] = __builtin_amdgcn_mfma_f32_16x16x32_bf16(k1, qf, a2[1], 0, 0, 0); } }
#pragma unroll
      for (int jj = 0; jj < 2; ++jj) { const int jt = jt0 + jj; const f32x4 acc = a2[jj];
          const int i = it * 16 + (lane & 15), j0 = jt * 16 + 4 * (lane >> 4);
          v2u o; o.x = pk2(j0 + 0 <= i ? acc[0] : 0.f, j0 + 1 <= i ? acc[1] : 0.f); o.y = pk2(j0 + 2 <= i ? acc[2] : 0.f, j0 + 3 <= i ? acc[3] : 0.f);
          *(LAS v2u*)(AL + i * 144 + j0 * 2) = o; } }
    LDS_WAIT(); __syncthreads();
    constexpr int NV = DV / 32;
    const int tt = w & 3, vh = w >> 2;
    f32x4 o[NV];
    { bf16x8 af[2], qf[4];
#pragma unroll
      for (int ks = 0; ks < 2; ++ks) af[ks] = ld_frag(AL, 144, tt * 16, ks, lane);
#pragma unroll
      for (int ks = 0; ks < 4; ++ks) qf[ks] = ld_frag(qL, 272, tt * 16, ks, lane);
#pragma unroll
      for (int n = 0; n < NV; ++n) o[n] = (f32x4){0.f, 0.f, 0.f, 0.f};
#pragma unroll
      for (int ks = 0; ks < 2; ++ks) { bf16x8 vf[NV];
#pragma unroll
          for (int n = 0; n < NV; ++n) vf[n] = ld_frag_tr<DV>(VT, (vh * NV + n) * 16, ks, lane);
#pragma unroll
          for (int n = 0; n < NV; ++n) o[n] = __builtin_amdgcn_mfma_f32_16x16x32_bf16(vf[n], af[ks], o[n], 0, 0, 0); }
#pragma unroll
      for (int ks = 0; ks < 4; ++ks) { bf16x8 sf[NV];
#pragma unroll
          for (int n = 0; n < NV; ++n) sf[n] = ld_frag(sL, 272, (vh * NV + n) * 16, ks, lane);
#pragma unroll
          for (int n = 0; n < NV; ++n) o[n] = __builtin_amdgcn_mfma_f32_16x16x32_bf16(sf[n], qf[ks], o[n], 0, 0, 0); } }
    { float s = 0.f;
#pragma unroll
      for (int n = 0; n < NV; ++n) s += (o[n][0] * o[n][0] + o[n][1] * o[n][1]) + (o[n][2] * o[n][2] + o[n][3] * o[n][3]);
      s += __shfl_xor(s, 16); s += __shfl_xor(s, 32);
      if (lane < 16) red[(tt * 16 + lane) * 2 + vh] = s; }
    LDS_WAIT(); __syncthreads();
    { const int t = tt * 16 + (lane & 15); const f32x2 rr = *(const LAS f32x2*)(red + t * 2); const float rstd = rsqrtf((rr[0] + rr[1]) * (1.f / DV) + EPS);
      const float* gn = GLA ? C.p.in[I_GLAG] : C.p.in[I_HGRNG]; bf16* ON = WSP(bf16, WS_ON); const int ocol = GLA ? h * 256 : 1024 + h * 128;
#pragma unroll
      for (int n = 0; n < NV; ++n) { const int v0 = (vh * NV + n) * 16 + 4 * (lane >> 4); const f32x4 g4 = *(const f32x4*)(gn + v0);
          const v2u gt = *(const v2u*)(PB + (size_t)(t0 + t) * NPROJ + gcol + v0);
          v2u ow; ow.x = pk2(o[n][0] * rstd * g4[0] * siluf_(bf2f(gt.x & 0xffffu)), o[n][1] * rstd * g4[1] * siluf_(bf2f(gt.x >> 16)));
          ow.y = pk2(o[n][2] * rstd * g4[2] * siluf_(bf2f(gt.y & 0xffffu)), o[n][3] * rstd * g4[3] * siluf_(bf2f(gt.y >> 16)));
          *(v2u*)(ON + (size_t)(t0 + t) * DM + ocol + v0) = ow; } }
    LDS_WAIT(); __syncthreads();
}
__device__ __forceinline__ void la2_phase_c(const Ctx& C) {
    const int w = blockIdx.x, bc = w >> 1, half = w & 1;
    PcRegs<256> g0, g1; PcRegs<128> h0, h1, h2, h3;
#define SB_ __builtin_amdgcn_sched_barrier(0)
    pc_load<256, true>(C, bc, half * 2 + 0, g0); SB_;
    pc_load<256, true>(C, bc, half * 2 + 1, g1); SB_; pc_part1<256, true>(C, g0); pc_part2<256, true>(C, bc, half * 2 + 0); SB_;
    pc_load<128, false>(C, bc, half * 4 + 0, h0); SB_; pc_part1<256, true>(C, g1); pc_part2<256, true>(C, bc, half * 2 + 1); SB_;
    pc_load<128, false>(C, bc, half * 4 + 1, h1); SB_; pc_part1<128, false>(C, h0); pc_part2<128, false>(C, bc, half * 4 + 0); SB_;
    pc_load<128, false>(C, bc, half * 4 + 2, h2); SB_; pc_part1<128, false>(C, h1); pc_part2<128, false>(C, bc, half * 4 + 1); SB_;
    pc_load<128, false>(C, bc, half * 4 + 3, h3); SB_; pc_part1<128, false>(C, h2); pc_part2<128, false>(C, bc, half * 4 + 2); SB_;
    pc_part1<128, false>(C, h3); pc_part2<128, false>(C, bc, half * 4 + 3);
#undef SB_
}

__device__ __forceinline__ void router_phase(const Ctx& C) {
    const int r0 = blockIdx.x * 32, lane = C.lane, w = C.wave;
    LAS float* rs = (LAS float*)C.lds;
    LAS float* part = (LAS float*)(C.lds + 256);
    const float* H2 = WSP(float, WS_H1); const float* g3 = C.p.in[I_NFFNG]; unsigned char* A3F = WSP(unsigned char, WS_A1B);
    for (int j = 0; j < 4; ++j) { const int row = r0 + w * 4 + j;
        const f32x4* xr = (const f32x4*)(H2 + (size_t)row * DM) + lane; const f32x4* gr = (const f32x4*)g3 + lane; f32x4 v[8]; float s = 0.f;
#pragma unroll
        for (int q = 0; q < 8; ++q) { v[q] = xr[64 * q]; s += (v[q].x * v[q].x + v[q].y * v[q].y) + (v[q].z * v[q].z + v[q].w * v[q].w); }
        const float rstd = rsqrtf(wave_sum(s) * (1.f / DM) + EPS);
        if (lane == 0) rs[w * 4 + j] = rstd;
        unsigned* o4 = (unsigned*)(A3F + (size_t)row * DM) + lane;
#pragma unroll
        for (int q = 0; q < 8; ++q) { const f32x4 gg = gr[64 * q]; o4[64 * q] = pk4_fp8(v[q].x * rstd * gg.x, v[q].y * rstd * gg.y, v[q].z * rstd * gg.z, v[q].w * rstd * gg.w); } }
    { const int rt = w & 1, kq = w >> 1, ar = lane & 15, kg = lane >> 4; const float* WRT = WSP(float, WS_WRT);
      f32x4 a0 = {0.f, 0.f, 0.f, 0.f}, a1 = a0, a2 = a0;
      const float* hp = H2 + (size_t)(r0 + rt * 16 + ar) * DM + kq * 512 + kg * 4; const float* wp = WRT + (size_t)ar * DM + kq * 512 + kg * 4;
      f32x4 a4 = *(const f32x4*)(hp), b0 = *(const f32x4*)(wp), b1 = *(const f32x4*)(wp + 16 * DM), b2 = *(const f32x4*)(wp + 32 * DM);
#pragma unroll 2
      for (int s = 0; s < 32; ++s) { const int sn = (s + 1) & 31;
          const f32x4 na = *(const f32x4*)(hp + sn * 16), n0 = *(const f32x4*)(wp + sn * 16), n1 = *(const f32x4*)(wp + 16 * DM + sn * 16), n2 = *(const f32x4*)(wp + 32 * DM + sn * 16);
#pragma unroll
          for (int i = 0; i < 4; ++i) { a0 = __builtin_amdgcn_mfma_f32_16x16x4f32(a4[i], b0[i], a0, 0, 0, 0); a1 = __builtin_amdgcn_mfma_f32_16x16x4f32(a4[i], b1[i], a1, 0, 0, 0); a2 = __builtin_amdgcn_mfma_f32_16x16x4f32(a4[i], b2[i], a2, 0, 0, 0); }
          a4 = na; b0 = n0; b1 = n1; b2 = n2; }
#pragma unroll
      for (int rg = 0; rg < 4; ++rg) { LAS float* pr = part + (kq * 32 + rt * 16 + 4 * kg + rg) * 48 + ar; pr[0] = a0[rg]; pr[16] = a1[rg]; pr[32] = a2[rg]; } }
    LDS_WAIT(); __syncthreads();
    LAS float* lgL = part + 4 * 32 * 48;
    for (int idx = C.tid; idx < 32 * 48; idx += 512) { const int t = idx / 48, c = idx % 48;
        lgL[idx] = ((part[(0 * 32 + t) * 48 + c] + part[(1 * 32 + t) * 48 + c]) + (part[(2 * 32 + t) * 48 + c] + part[(3 * 32 + t) * 48 + c])) * rs[t]; }
    LDS_WAIT(); __syncthreads();
    if (C.tid < 32) { const int t = C.tid, row = r0 + t; const LAS float* lg = lgL + t * 48;
        const float* brg = C.p.in[I_BRG]; const float* bre = C.p.in[I_BRE];
        int grp = 0; float gm = -3.0e38f;
        for (int g = 0; g < 4; ++g) { const float x = lg[32 + g] + brg[g]; if (x > gm) { gm = x; grp = g; } }
        float gs = 0.f; for (int g = 0; g < 4; ++g) gs += __expf(lg[32 + g] + brg[g] - gm);
        const float pg = 1.f / gs;
        float v1 = -3.0e38f, v2 = -3.0e38f; int i1 = 0, i2 = 0;
        for (int j = 0; j < 8; ++j) { const float x = lg[grp * 8 + j] + bre[grp * 8 + j];
            if (x > v1) { v2 = v1; i2 = i1; v1 = x; i1 = j; } else if (x > v2) { v2 = x; i2 = j; } }
        const float e2 = __expf(v2 - v1); const float w1 = pg / (1.f + e2), w2 = pg * e2 / (1.f + e2);
        unsigned* cnt = WSP(unsigned, WS_CTL) + CW_CNT; int* list = WSP(int, WS_LIST); float* gw = WSP(float, WS_GATEW);
        const int ea = grp * 8 + i1, eb = grp * 8 + i2;
        const unsigned pa = atomicAdd(cnt + ea * 64, 1u); list[ea * 8192 + pa] = row * 2; gw[row * 2] = w1;
        const unsigned pb = atomicAdd(cnt + eb * 64, 1u); list[eb * 8192 + pb] = row * 2 + 1; gw[row * 2 + 1] = w2; }
}

__device__ __forceinline__ void final_phase(const Ctx& C) {
    const int lane = C.lane; const float* H2 = WSP(float, WS_H1); const unsigned char* Y = WSP(unsigned char, WS_Y); const float* gw = WSP(float, WS_GATEW); const float* gf = C.p.in[I_NFING];
    for (int j = 0; j < 4; ++j) { const int row = blockIdx.x * 32 + C.wave * 4 + j; const float w0 = gw[row * 2], w1 = gw[row * 2 + 1];
        const f32x4* xr = (const f32x4*)(H2 + (size_t)row * DM) + lane; const unsigned* y0 = (const unsigned*)(Y + (size_t)(row * 2) * DM) + lane; const unsigned* y1 = (const unsigned*)(Y + (size_t)(row * 2 + 1) * DM) + lane;
        f32x4 v[8]; float s = 0.f;
#pragma unroll
        for (int q = 0; q < 8; ++q) { const unsigned a = __builtin_nontemporal_load(y0 + 64 * q), b = __builtin_nontemporal_load(y1 + 64 * q); f32x4 x = __builtin_nontemporal_load(xr + 64 * q);
            const f32x2 a01 = __builtin_amdgcn_cvt_pk_f32_fp8((int)a, false), a23 = __builtin_amdgcn_cvt_pk_f32_fp8((int)a, true), b01 = __builtin_amdgcn_cvt_pk_f32_fp8((int)b, false), b23 = __builtin_amdgcn_cvt_pk_f32_fp8((int)b, true);
            x.x += w0 * a01[0] + w1 * b01[0]; x.y += w0 * a01[1] + w1 * b01[1]; x.z += w0 * a23[0] + w1 * b23[0]; x.w += w0 * a23[1] + w1 * b23[1];
            v[q] = x; s += (x.x * x.x + x.y * x.y) + (x.z * x.z + x.w * x.w); }
        const float rstd = rsqrtf(wave_sum(s) * (1.f / DM) + EPS);
        f32x4* o = (f32x4*)(C.p.out + (size_t)row * DM) + lane; const f32x4* gr = (const f32x4*)gf + lane;
#pragma unroll
        for (int q = 0; q < 8; ++q) __builtin_nontemporal_store(v[q] * rstd * gr[64 * q], o + 64 * q); }
}

constexpr int N_PHASES = 12;
__global__ void __launch_bounds__(512, 2) mk_fwd(Params p) {
    extern __shared__ __attribute__((aligned(16))) unsigned char lds_raw[];
    Ctx C; C.p = p; C.lds = (LAS unsigned char*)lds_raw; C.tid = threadIdx.x; C.lane = C.tid & 63; C.wave = __builtin_amdgcn_readfirstlane(C.tid >> 6);
    C.G = gridDim.x; { const int bx = blockIdx.x; C.vcu = (C.G % 8 == 0) ? (bx % 8) * (C.G / 8) + bx / 8 : bx; }
    volatile LAS unsigned* MISC = (volatile LAS unsigned*)(C.lds + MISC_OFF);
    const int lo = p.ph_lo, hi = p.ph_hi;
    const bool multi = (hi - lo) > 1;
    XcdBarrier bar; bar.bar = WSP(unsigned, WS_CTL) + CW_BAR; bar.x = 0; bar.st = MISC;
    if (multi) { if (C.tid < 64) MISC[C.tid] = 0u; __syncthreads(); bar = xcd_barrier_post(WSP(unsigned, WS_CTL) + CW_BAR, MISC); }
#define PHASE_BEGIN(k) if (lo <= (k) && (k) < hi) { { int t_ = threadIdx.x; asm volatile("" : "+v"(t_)); C.tid = t_; C.lane = t_ & 63; C.wave = __builtin_amdgcn_readfirstlane(t_ >> 6); \
        }
#define PHASE_END(k) if ((k) + 1 < hi) xcd_barrier(bar); }
#define GEMM_PHASE(kind) gemm_phase_fast<kind>(C)
    PHASE_BEGIN(0) p0_prologue(C); PHASE_END(0)
    PHASE_BEGIN(1) GEMM_PHASE(GK_PROJ); if (blockIdx.x >= 224) convert_expert_items(C, 0, NX_P1, (blockIdx.x - 224) * 8 + C.wave, 32 * 8); PHASE_END(1)
    PHASE_BEGIN(2) la2_phase_a(C); PHASE_END(2)
    PHASE_BEGIN(3) la_phase_scan(C); GEMM_PHASE(GK_XPRE); if (blockIdx.x >= 128) convert_expert_items(C, NX_P1, NX_P1 + NX_XPRE, (blockIdx.x - 128) * 8 + C.wave, 128 * 8); PHASE_END(3)
    PHASE_BEGIN(4) la2_phase_c(C); PHASE_END(4)
    PHASE_BEGIN(5) GEMM_PHASE(GK_OUT); GEMM_PHASE(GK_SCORE); if (blockIdx.x >= 128) { convert_expert_items(C, NX_P1 + NX_XPRE, NX_DEFER, (blockIdx.x - 128) * 8 + C.wave, 128 * 8); __syncthreads(); } GEMM_PHASE(GK_PV); PHASE_END(5)
    PHASE_BEGIN(8) if (blockIdx.x & 8) { convert_expert_items(C, NX_DEFER, NX_TOTAL, C.vcu * 8 + C.wave, C.G * 8); __syncthreads(); router_phase(C); } else { router_phase(C); __syncthreads(); convert_expert_items(C, NX_DEFER, NX_TOTAL, C.vcu * 8 + C.wave, C.G * 8); } PHASE_END(8)
    PHASE_BEGIN(9) GEMM_PHASE(GK_MOE1); GEMM_PHASE(GK_MOE2); PHASE_END(9)
    PHASE_BEGIN(11) final_phase(C); PHASE_END(11)
}

extern "C" void kernel_launch(void* const* d_in, const int* in_sizes, int n_in, void* d_out, int out_size, void* d_ws, size_t ws_size, hipStream_t stream) {
    static int grid = 0;
    if (grid == 0) {
        if (n_in != 24 || out_size != MTOK * DM || ws_size < WS_END) { fprintf(stderr, "kernel_launch: unexpected shapes (n_in %d out %d ws %zu need %zu)\n", n_in, out_size, ws_size, (size_t)WS_END); grid = -1; return; }
        if (hipFuncSetAttribute((const void*)mk_fwd, hipFuncAttributeMaxDynamicSharedMemorySize, LDS_BYTES) != hipSuccess) { fprintf(stderr, "kernel_launch: hipFuncSetAttribute failed\n"); grid = -1; return; }
        int dev = 0, cus = 0; (void)hipGetDevice(&dev); (void)hipDeviceGetAttribute(&cus, hipDeviceAttributeMultiprocessorCount, dev);
        int per_cu = 0; (void)hipOccupancyMaxActiveBlocksPerMultiprocessor(&per_cu, (const void*)mk_fwd, 512, LDS_BYTES); (void)hipGetLastError();
        if (cus != 256 || per_cu < 1) fprintf(stderr, "kernel_launch: note: cus %d per_cu %d\n", cus, per_cu);
        grid = 256;
    }
    if (grid < 0) return;
    (void)hipMemsetAsync((char*)d_ws + WS_CTL, 0, CTL_ZERO_BYTES, stream);
    Params a{};
    for (int i = 0; i < 24; ++i) a.in[i] = (const float*)d_in[i];
    a.out = (float*)d_out; a.ws = (unsigned char*)d_ws;
#if MK_ONE_LAUNCH
    a.ph_lo = 0; a.ph_hi = N_PHASES;
    hipLaunchKernelGGL(mk_fwd, dim3(grid), dim3(512), LDS_BYTES, stream, a);
#else
    for (int ph = 0; ph < N_PHASES; ++ph) { a.ph_lo = ph; a.ph_hi = ph + 1; hipLaunchKernelGGL(mk_fwd, dim3(grid), dim3(512), LDS_BYTES, stream, a); }
#endif
}
```

```cpp
#include <hip/hip_runtime.h>
#include <cstdio>
#include <cstdint>

#ifndef MK_ONE_LAUNCH
#define MK_ONE_LAUNCH 1
#endif

#define GAS __attribute__((address_space(1)))
#define LAS __attribute__((address_space(3)))
typedef unsigned short bf16;
typedef unsigned v4u __attribute__((ext_vector_type(4)));
typedef unsigned v2u __attribute__((ext_vector_type(2)));
typedef float f32x4 __attribute__((ext_vector_type(4)));
typedef float f32x2 __attribute__((ext_vector_type(2)));
typedef short bf16x8 __attribute__((ext_vector_type(8)));
typedef GAS unsigned gu32;
typedef int v8i __attribute__((ext_vector_type(8)));
typedef int v4i __attribute__((ext_vector_type(4)));

constexpr int DM = 2048, MTOK = 8192, SEQ = 4096, MEMR = 512, NPROJ = 7680, INW = 7184;
constexpr int NEXP = 32;
constexpr float EPS = 1e-6f;
constexpr int C_GQ = 0, C_GK = 512, C_GV = 1024, C_GG = 2048, C_GA = 3072, C_HQ = 3584, C_HK = 4608, C_HV = 5632, C_HG = 6656;

constexpr size_t MiB = 1ull << 20;
constexpr size_t WS_CTL = 0, CTL_ZERO_BYTES = 128 * 1024;
constexpr size_t WS_WTIN = 1 * MiB;
constexpr size_t WS_WTOUT = 31 * MiB;
constexpr size_t WS_WQN = 39 * MiB;
constexpr size_t WS_WOT = 47 * MiB;
constexpr size_t WS_WTKV = 55 * MiB;
constexpr size_t WS_WRT = 71 * MiB;
constexpr size_t WS_EXP1 = 72 * MiB;
constexpr size_t WS_EXP2 = 328 * MiB;
constexpr size_t WS_A1B = 456 * MiB;
constexpr size_t WS_MEMN = 488 * MiB;
constexpr size_t WS_KV = 490 * MiB;
constexpr size_t WS_PB = 494 * MiB;
constexpr size_t WS_Y = WS_PB + 48 * MiB;
constexpr size_t WS_LA = 614 * MiB;
constexpr size_t WS_LF = 630 * MiB;
constexpr size_t WS_UT = 662 * MiB;
constexpr size_t WS_DB = 726 * MiB;
constexpr size_t WS_ON = 727 * MiB;
constexpr size_t WS_H1 = 759 * MiB;
constexpr size_t WS_H1B = 823 * MiB;
constexpr size_t WS_MT = 855 * MiB;
constexpr size_t WS_NT = 863 * MiB;
constexpr size_t WS_PBUF = 871 * MiB;
constexpr size_t WS_LIST = 887 * MiB;
constexpr size_t WS_GATEW = 888 * MiB;
constexpr size_t WS_HID = 889 * MiB;
constexpr size_t WS_END = 913 * MiB;
constexpr int CW_TMO = 0, CW_BAR = 4096, CW_CNT = 8192, CW_SS1 = 16384, CW_MT = 24576;
static_assert((CW_MT + 16 * 96) * 4 <= (int)CTL_ZERO_BYTES, "ctl");

constexpr int LDS_BYTES = 163840;
constexpr int RING_BYTES = 131072;
constexpr int EPI_OFF = RING_BYTES;
constexpr int TBL_OFF = RING_BYTES + 8192;
constexpr int MISC_OFF = LDS_BYTES - 256;

#define LDS_WAIT() asm volatile("s_waitcnt lgkmcnt(0)" ::: "memory")
#define VM_WAIT() asm volatile("s_waitcnt vmcnt(0)" ::: "memory")
#define RLX_AGENT __ATOMIC_RELAXED, __HIP_MEMORY_SCOPE_AGENT
__device__ __forceinline__ float bf2f(unsigned v) { return __uint_as_float(v << 16); }
__device__ __forceinline__ unsigned f2bf(float f) { unsigned u = __float_as_uint(f); return (u + 0x7fffu + ((u >> 16) & 1u)) >> 16; }
__device__ __forceinline__ unsigned pk2(float lo, float hi) { return f2bf(lo) | (f2bf(hi) << 16); }
__device__ __forceinline__ float wave_sum(float v) {
#pragma unroll
    for (int o = 1; o < 64; o <<= 1) v += __shfl_xor(v, o);
    return v;
}
__device__ __forceinline__ float sigmoidf_(float x) { return 1.f / (1.f + __expf(-x)); }
__device__ __forceinline__ float siluf_(float x) { return x / (1.f + __expf(-x)); }
__device__ __forceinline__ float logsigmoidf_(float x) { return fminf(x, 0.f) - __logf(1.f + __expf(-fabsf(x))); }

#define XB_TMO      128
#define XB_XCNT(j)  (256  + 64 * (j))
#define XB_XSUB(j)  (1280 + 64 * (j))
#define XB_XGEN(j)  (2304 + 64 * (j))
#define XB_TOP      3328
#define XB_TOPGEN   3392
#define XCD_BAR_WORDS 3456
#define XB_SPIN_CAP (1u << 18)
__device__ __forceinline__ unsigned xb_ld(unsigned* p)              { return __hip_atomic_load(p, __ATOMIC_RELAXED, __HIP_MEMORY_SCOPE_AGENT); }
__device__ __forceinline__ unsigned xb_add(unsigned* p, unsigned v) { return __hip_atomic_fetch_add(p, v, __ATOMIC_RELAXED, __HIP_MEMORY_SCOPE_AGENT); }
__device__ __forceinline__ unsigned xb_xcc_id() { return (unsigned)__builtin_amdgcn_s_getreg((3 << 11) | 20) & 0xFu; }
#define XB_SPIN(cond, bar) do { unsigned _sp = 0; while (cond) { __builtin_amdgcn_s_sleep(1); \
    if ((++_sp & 255u) == 0u) { if (xb_ld(&(bar)[XB_TMO])) break; if (_sp > XB_SPIN_CAP) { atomicAdd(&(bar)[XB_TMO], 1u); break; } } } } while (0)
struct XcdBarrier { unsigned* bar; unsigned x; volatile LAS unsigned* st; };
__device__ __forceinline__ XcdBarrier xcd_barrier_post(unsigned* bar, volatile LAS unsigned* st) {
    XcdBarrier b; b.bar = bar; b.x = xb_xcc_id(); b.st = st;
    if (threadIdx.x == 0) (void)xb_add(&bar[XB_XCNT(b.x)], 1u);
    return b;
}
__device__ __forceinline__ void xcd_barrier_complete(unsigned* bar, unsigned x, unsigned& nloc, unsigned& nx) {
    const unsigned G = gridDim.x * gridDim.y * gridDim.z;
    unsigned sum, cnt, mine, sp = 0u;
    for (;;) {
        sum = 0u; cnt = 0u; mine = 0u;
#pragma unroll
        for (unsigned j = 0; j < 16; ++j) { const unsigned c = xb_ld(&bar[XB_XCNT(j)]); sum += c; cnt += (c > 0u) ? 1u : 0u; mine = (j == x) ? c : mine; }
        if (sum == G) break;
        __builtin_amdgcn_s_sleep(1);
        if ((++sp & 255u) == 0u) { if (xb_ld(&bar[XB_TMO])) break; if (sp > XB_SPIN_CAP) { atomicAdd(&bar[XB_TMO], 1u); break; } }
    }
    nloc = mine > 0u ? mine : 1u; nx = cnt > 0u ? cnt : 1u;
}
__device__ __forceinline__ void xcd_barrier(const XcdBarrier& b) {
    asm volatile("s_waitcnt vmcnt(0)" ::: "memory");
    __syncthreads();
    if (threadIdx.x == 0) {
        unsigned* bar = b.bar;
        __builtin_amdgcn_s_waitcnt(0);
        unsigned nloc = b.st[0], nx = b.st[1];
        if (nloc == 0u) { xcd_barrier_complete(bar, b.x, nloc, nx); b.st[0] = nloc; b.st[1] = nx; }
        const unsigned old = xb_add(&bar[XB_XSUB(b.x)], 1u);
        const unsigned gen = old / nloc;
        if (old + 1u == (gen + 1u) * nloc) {
            __builtin_amdgcn_fence(__ATOMIC_RELEASE, "agent");
            asm volatile("s_waitcnt vmcnt(0)" ::: "memory");
            const unsigned og = xb_add(&bar[XB_TOP], 1u);
            const unsigned tg = og / nx;
            if (og + 1u == (tg + 1u) * nx) xb_add(&bar[XB_TOPGEN], 1u);
            else XB_SPIN(xb_ld(&bar[XB_TOPGEN]) == tg, bar);
            __builtin_amdgcn_fence(__ATOMIC_ACQUIRE, "agent");
            xb_add(&bar[XB_XGEN(b.x)], 1u);
            asm volatile("s_waitcnt vmcnt(0)" ::: "memory");
        } else {
            XB_SPIN(xb_ld(&bar[XB_XGEN(b.x)]) == gen, bar);
            __builtin_amdgcn_fence(__ATOMIC_ACQUIRE, "agent");
            asm volatile("s_waitcnt vmcnt(0)" ::: "memory");
        }
    }
    __syncthreads();
}

struct Params { const float* in[24]; float* out; unsigned char* ws; int ph_lo, ph_hi; };
enum { I_X = 0, I_MEM, I_NMIXG, I_WIN, I_WAUP, I_BALPHA, I_GLAG, I_LBLOG, I_HGRNG, I_WMIXOUT, I_NXG, I_NMEMG, I_WQ, I_WKV, I_WO, I_NFFNG, I_WRG, I_BRG, I_WRE, I_BRE,
       I_WEG, I_WEU, I_WED, I_NFING };

struct Ctx {
    Params p; LAS unsigned char* lds; int tid, lane, wave, vcu, G;
};
#define WSP(T, off) ((T*)(C.p.ws + (off)))

__device__ __forceinline__ int rowmap(int kind, int n) {
    if (kind == 0) return n;
    if (kind == 1) return n < 3072 ? n : (n < 3088 ? -1 : (n < INW ? n + 496 : -1));
    if (kind == 2) return ((n >> 7) << 8) + (n & 127);
    return ((n >> 7) << 8) + 128 + (n & 127);
}
__device__ __forceinline__ void transpose_load(const float* W, int ldsrc, int nvalid, int k0, int n0, int lane, float (&tv)[32]) {
    const int nn = n0 + (lane & 31); const bool ok = nn < nvalid;
    const float* wp = W + (size_t)(k0 + (lane >> 5)) * ldsrc + (ok ? nn : 0);
#pragma unroll
    for (int i = 0; i < 32; ++i) tv[i] = __builtin_nontemporal_load(wp + (size_t)(2 * i) * ldsrc);
    if (!ok) {
#pragma unroll
        for (int i = 0; i < 32; ++i) tv[i] = 0.f; }
}
__device__ __forceinline__ void transpose_finish(const float (&tv)[32], int nvalid, int k0, int n0, bf16* WT, int lddst, int kind, LAS float* scr, int lane) {
#pragma unroll
    for (int i = 0; i < 32; ++i) { const int kk = 2 * i + (lane >> 5); scr[kk * 33 + (lane & 31)] = tv[i]; }
    LDS_WAIT(); asm volatile("" ::: "memory");
    const int c = lane & 7;
#pragma unroll
    for (int j = 0; j < 4; ++j) { const int n = (lane >> 3) + 8 * j; const LAS float* s = scr + (8 * c) * 33 + n;
        v4u o; o.x = pk2(s[0 * 33], s[1 * 33]); o.y = pk2(s[2 * 33], s[3 * 33]); o.z = pk2(s[4 * 33], s[5 * 33]); o.w = pk2(s[6 * 33], s[7 * 33]);
        const int r = (n0 + n < nvalid) ? rowmap(kind, n0 + n) : -1;
        if (r >= 0) *(v4u*)(WT + (size_t)r * lddst + k0 + 8 * c) = o; }
    LDS_WAIT(); asm volatile("" ::: "memory");
}
__device__ __forceinline__ void transpose_item(const float* W, int ldsrc, int nvalid, int k0, int n0, bf16* WT, int lddst, int kind, LAS float* scr, int lane) {
    float tv[32]; transpose_load(W, ldsrc, nvalid, k0, n0, lane, tv); transpose_finish(tv, nvalid, k0, n0, WT, lddst, kind, scr, lane);
}
__device__ __forceinline__ void rms_row_to_bf16(const float* xrow, const float* g, bf16* orow, int lane) {
    const f32x4* xr = (const f32x4*)xrow + lane; const f32x4* gr = (const f32x4*)g + lane;
    f32x4 v[8]; float s = 0.f;
#pragma unroll
    for (int j = 0; j < 8; ++j) { v[j] = __builtin_nontemporal_load(xr + 64 * j); s += (v[j].x * v[j].x + v[j].y * v[j].y) + (v[j].z * v[j].z + v[j].w * v[j].w); }
    const float rstd = rsqrtf(wave_sum(s) * (1.f / DM) + EPS);
    v2u* o8 = (v2u*)orow + lane;
#pragma unroll
    for (int j = 0; j < 8; ++j) { const f32x4 gg = gr[64 * j]; v2u w; w.x = pk2(v[j].x * rstd * gg.x, v[j].y * rstd * gg.y); w.y = pk2(v[j].z * rstd * gg.z, v[j].w * rstd * gg.w); o8[64 * j] = w; }
}
constexpr float WSCALE = 64.f, WSCALE_INV = 1.f / 64.f;
__device__ __forceinline__ unsigned pk4_fp8(float a, float b, float c, float d) {
    a = __builtin_amdgcn_fmed3f(a, -448.f, 448.f); b = __builtin_amdgcn_fmed3f(b, -448.f, 448.f); c = __builtin_amdgcn_fmed3f(c, -448.f, 448.f); d = __builtin_amdgcn_fmed3f(d, -448.f, 448.f);
    int r = __builtin_amdgcn_cvt_pk_fp8_f32(a, b, 0, false); r = __builtin_amdgcn_cvt_pk_fp8_f32(c, d, r, true); return (unsigned)r; }
struct XItem { const float* W; unsigned char* WT; int ld, k0, n0, ldd, kind; };
__device__ __forceinline__ XItem expert_item(const Ctx& C, int it) {
    XItem x; const int e = it / 1536, q = it % 1536, which = q >> 9, j = q & 511;
    if (which == 0) { x.W = C.p.in[I_WEG] + (size_t)e * 2048 * 1024; x.ld = 1024; x.k0 = 128 * (j / 32); x.n0 = 32 * (j % 32); x.WT = WSP(unsigned char, WS_EXP1) + (size_t)e * 2048 * 2048; x.ldd = 2048; x.kind = 2; }
    else if (which == 1) { x.W = C.p.in[I_WEU] + (size_t)e * 2048 * 1024; x.ld = 1024; x.k0 = 128 * (j / 32); x.n0 = 32 * (j % 32); x.WT = WSP(unsigned char, WS_EXP1) + (size_t)e * 2048 * 2048; x.ldd = 2048; x.kind = 3; }
    else { x.W = C.p.in[I_WED] + (size_t)e * 1024 * 2048; x.ld = 2048; x.k0 = 128 * (j / 64); x.n0 = 32 * (j % 64); x.WT = WSP(unsigned char, WS_EXP2) + (size_t)e * 2048 * 1024; x.ldd = 1024; x.kind = 0; }
    return x;
}
__device__ __forceinline__ void x_load(const XItem& x, int lane, float (&tv)[64]) {
    const float* wp = x.W + (size_t)(x.k0 + (lane >> 5)) * x.ld + x.n0 + (lane & 31);
#pragma unroll
    for (int i = 0; i < 64; ++i) tv[i] = __builtin_nontemporal_load(wp + (size_t)(2 * i) * x.ld);
}
__device__ __forceinline__ void x_finish(const float (&tv)[64], const XItem& x, LAS float* scr, int lane) {
#pragma unroll
    for (int i = 0; i < 64; ++i) { const int kk = 2 * i + (lane >> 5); scr[kk * 33 + (lane & 31)] = tv[i]; }
    LDS_WAIT(); asm volatile("" ::: "memory");
    const int c = lane & 7;
#pragma unroll
    for (int j = 0; j < 4; ++j) { const int n = (lane >> 3) + 8 * j; const LAS float* s = scr + (16 * c) * 33 + n;
        v4u o; o.x = pk4_fp8(s[0 * 33] * WSCALE, s[1 * 33] * WSCALE, s[2 * 33] * WSCALE, s[3 * 33] * WSCALE); o.y = pk4_fp8(s[4 * 33] * WSCALE, s[5 * 33] * WSCALE, s[6 * 33] * WSCALE, s[7 * 33] * WSCALE);
        o.z = pk4_fp8(s[8 * 33] * WSCALE, s[9 * 33] * WSCALE, s[10 * 33] * WSCALE, s[11 * 33] * WSCALE); o.w = pk4_fp8(s[12 * 33] * WSCALE, s[13 * 33] * WSCALE, s[14 * 33] * WSCALE, s[15 * 33] * WSCALE);
        __builtin_nontemporal_store(o, (v4u*)(x.WT + (size_t)rowmap(x.kind, x.n0 + n) * x.ldd + x.k0 + 16 * c)); }
    LDS_WAIT(); asm volatile("" ::: "memory");
}
constexpr int NX_TOTAL = 32 * 1536;
constexpr int NX_P1 = 32 * 8 * 12, NX_XPRE = 128 * 8 * 4, NX_SCORE = 128 * 8 * 14;
constexpr int NX_DEFER = NX_P1 + NX_XPRE + NX_SCORE;
__device__ __forceinline__ void convert_expert_items(const Ctx& C, int ibeg, int iend, int widx, int nw) {
    LAS float* scr = (LAS float*)(C.lds + C.wave * 16896);
    for (int it = ibeg + widx; it < iend; it += nw) { const XItem x = expert_item(C, it); float tv[64]; x_load(x, C.lane, tv); x_finish(tv, x, scr, C.lane); }
}
__device__ __forceinline__ void p0_prologue(const Ctx& C) {
    LAS float* scr = (LAS float*)(C.lds + C.wave * 16896);
    const int gw = C.vcu * 8 + C.wave, NGW = C.G * 8;
    const int gt = gw * 64 + C.lane, NGT = NGW * 64;
    constexpr int I0 = 32 * 225, I1 = 32 * 64, I2 = 32 * 64, I3 = 32 * 128;
    constexpr int NITEMS = I0 + I1 + I2 + I3;
    for (int it = gw; it < NITEMS; it += NGW) {
        int r = it;
        if (r < I0) { const int kb = r / 225, nb = r % 225; transpose_item(C.p.in[I_WIN], INW, INW, 64 * kb, 32 * nb, WSP(bf16, WS_WTIN), DM, 1, scr, C.lane); continue; } r -= I0;
        if (r < I1) { const int kb = r / 64, nb = r % 64; transpose_item(C.p.in[I_WMIXOUT], DM, DM, 64 * kb, 32 * nb, WSP(bf16, WS_WTOUT), DM, 0, scr, C.lane); continue; } r -= I1;
        if (r < I2) { const int kb = r / 64, nb = r % 64; transpose_item(C.p.in[I_WO], DM, DM, 64 * kb, 32 * nb, WSP(bf16, WS_WOT), DM, 0, scr, C.lane); continue; } r -= I2;
        { const int kb = r / 128, nb = r % 128; transpose_item(C.p.in[I_WKV], 4096, 4096, 64 * kb, 32 * nb, WSP(bf16, WS_WTKV), DM, 0, scr, C.lane); }
    }
    { const float* wq = C.p.in[I_WQ]; const float* g = C.p.in[I_NXG]; bf16* o = WSP(bf16, WS_WQN);
      for (int id = gt; id < DM * DM / 8; id += NGT) { const int k = id >> 8; const float gk = g[k]; const f32x4 a = __builtin_nontemporal_load((const f32x4*)(wq + (size_t)id * 8)), b = __builtin_nontemporal_load((const f32x4*)(wq + (size_t)id * 8 + 4));
          v4u w; w.x = pk2(a.x * gk, a.y * gk); w.y = pk2(a.z * gk, a.w * gk); w.z = pk2(b.x * gk, b.y * gk); w.w = pk2(b.z * gk, b.w * gk); *(v4u*)(o + (size_t)id * 8) = w; } }
    { const float* win = C.p.in[I_WIN]; const float* wup = C.p.in[I_WAUP]; bf16* o = WSP(bf16, WS_WTIN);
      for (int id = gt; id < 512 * 256; id += NGT) { const int c = id >> 8, k8 = id & 255; float up[16];
#pragma unroll
          for (int j = 0; j < 16; ++j) up[j] = wup[j * 512 + c];
          float r[8];
#pragma unroll
          for (int kk = 0; kk < 8; ++kk) { const float* wr = win + (size_t)(k8 * 8 + kk) * INW + 3072; float s = 0.f;
#pragma unroll
              for (int j = 0; j < 16; ++j) s += wr[j] * up[j];
              r[kk] = s; }
          v4u w; w.x = pk2(r[0], r[1]); w.y = pk2(r[2], r[3]); w.z = pk2(r[4], r[5]); w.w = pk2(r[6], r[7]);
          *(v4u*)(o + (size_t)(C_GA + c) * DM + k8 * 8) = w; } }
    { const float* wre = C.p.in[I_WRE]; const float* wrg = C.p.in[I_WRG]; const float* g = C.p.in[I_NFFNG]; float* o = WSP(float, WS_WRT);
      for (int id = gt; id < 48 * DM; id += NGT) { const int c = id >> 11, k = id & 2047; float v = 0.f;
          if (c < 32) v = g[k] * wre[k * 32 + c]; else if (c < 36) v = g[k] * wrg[k * 4 + (c - 32)];
          o[id] = v; } }
    for (int m = gw; m < MTOK + MEMR; m += NGW) {
        if (m < MTOK) rms_row_to_bf16(C.p.in[I_X] + (size_t)m * DM, C.p.in[I_NMIXG], WSP(bf16, WS_A1B) + (size_t)m * DM, C.lane);
        else rms_row_to_bf16(C.p.in[I_MEM] + (size_t)(m - MTOK) * DM, C.p.in[I_NMEMG], WSP(bf16, WS_MEMN) + (size_t)(m - MTOK) * DM, C.lane);
    }
}

struct Unit { const char* A; const char* B; bf16* Cb; unsigned lda2, ldb2; int ldc; int pm, pn, mode, e, mtl, cnt, mtg; };
enum { GK_PROJ = 1, GK_XPRE = 2, GK_OUT = 3, GK_SCORE = 4, GK_PV = 5, GK_MOE1 = 7, GK_MOE2 = 8 };

__device__ __forceinline__ void static_tile(int L, int nM, int nN, int& pm, int& pn) {
    const int nwg = nM * nN; int wgid = L;
    { const int q = nwg / 8, r = nwg % 8, xcd = wgid % 8, off = wgid / 8; wgid = (xcd < r ? xcd * (q + 1) : r * (q + 1) + (xcd - r) * q) + off; }
    const int nig = 2 * nN, gid = wgid / nig, fm = gid * 2, gsz = (nM - fm) < 2 ? (nM - fm) : 2;
    pm = fm + ((wgid % nig) % gsz); pn = (wgid % nig) / gsz;
}
__device__ __forceinline__ int gemm_K(int kind) { return kind == GK_XPRE ? 512 : ((kind == GK_PV || kind == GK_MOE2) ? 1024 : 2048); }

__device__ __forceinline__ bool unit_next(const Ctx& C, int kind, int i, Unit& u) {
    const int bx = blockIdx.x, G = C.G;
    u.e = 0; u.mtl = 0; u.cnt = 0; u.mtg = 0; u.mode = 0; u.Cb = nullptr; u.ldc = 0;
    if (kind == GK_PROJ) {
        const int L = i * G + bx; if (L >= 992) return false;
        u.lda2 = 4096; u.ldb2 = 4096;
        if (L < 960) { static_tile(L, 32, 30, u.pm, u.pn);
            u.A = (const char*)WSP(bf16, WS_A1B) + (size_t)u.pm * 256 * 4096; u.B = (const char*)WSP(bf16, WS_WTIN) + (size_t)u.pn * 256 * 4096;
            u.mode = 0;
            u.Cb = WSP(bf16, WS_PB) + (size_t)u.pm * 256 * NPROJ + u.pn * 256; u.ldc = NPROJ; }
        else { const int j = L - 960; u.pm = j >> 4; u.pn = j & 15;
            u.A = (const char*)WSP(bf16, WS_MEMN) + (size_t)u.pm * 256 * 4096; u.B = (const char*)WSP(bf16, WS_WTKV) + (size_t)u.pn * 256 * 4096;
            u.mode = 0; u.Cb = WSP(bf16, WS_KV) + (size_t)u.pm * 256 * 4096 + u.pn * 256; u.ldc = 4096; }
        return true;
    }
    if (kind == GK_XPRE) {
        const int L = i * G + bx; if (L >= 128) return false;
        const int q = L & 63, b = q >> 5, h = (q >> 3) & 3, t = q & 7; u.pm = 0; u.pn = t;
        if (L < 64) {
            u.A = (const char*)WSP(bf16, WS_KV) + (size_t)(b * 256) * 8192 + h * 1024; u.lda2 = 8192;
            u.B = (const char*)WSP(bf16, WS_WQN) + (size_t)(t * 256) * 4096 + h * 1024; u.ldb2 = 4096;
            u.Cb = WSP(bf16, WS_MT) + (size_t)(b * 1024 + h * 256) * 2048 + t * 256; u.ldc = 2048;
        } else {
            u.A = (const char*)WSP(bf16, WS_WOT) + (size_t)(t * 256) * 4096 + h * 1024; u.lda2 = 4096;
            u.B = (const char*)WSP(bf16, WS_KV) + (size_t)(b * 256) * 8192 + 4096 + h * 1024; u.ldb2 = 8192;
            u.Cb = WSP(bf16, WS_NT) + (size_t)(b * 2048 + t * 256) * 1024 + h * 256; u.ldc = 1024;
        }
        return true;
    }
    if (kind == GK_OUT) {
        const int L = i * G + bx; if (L >= 256) return false;
        static_tile(L, 32, 8, u.pm, u.pn); u.lda2 = 4096; u.ldb2 = 4096;
        u.A = (const char*)WSP(bf16, WS_ON) + (size_t)u.pm * 256 * 4096; u.B = (const char*)WSP(bf16, WS_WTOUT) + (size_t)u.pn * 256 * 4096;
        return true;
    }
    if (kind == GK_SCORE) {
        const int L = i * G + bx; if (L >= 128) return false;
        static_tile(L, 32, 4, u.pm, u.pn); u.lda2 = 4096; u.ldb2 = 4096;
        u.A = (const char*)WSP(bf16, WS_H1B) + (size_t)u.pm * 256 * 4096; u.B = (const char*)WSP(bf16, WS_MT) + (size_t)((u.pm >> 4) * 1024 + u.pn * 256) * 4096;
        return true;
    }
    if (kind == GK_PV) {
        const int L = i * G + bx; if (L >= 256) return false;
        static_tile(L, 32, 8, u.pm, u.pn); u.lda2 = 2048; u.ldb2 = 2048;
        u.A = (const char*)WSP(bf16, WS_PBUF) + (size_t)u.pm * 256 * 2048; u.B = (const char*)WSP(bf16, WS_NT) + (size_t)((u.pm >> 4) * 2048 + u.pn * 256) * 2048;
        return true;
    }
    {
        const LAS int* ts = (const LAS int*)(C.lds + TBL_OFF); const LAS int* cn = ts + 40;
        const int L = i * G + (kind == GK_MOE2 ? G - 1 - C.vcu : C.vcu); const int TT8 = ts[32] * 8; if (L >= TT8) return false;
        int e = 0;
        for (int j = 1; j < 32; ++j) if (L >= ts[j] * 8) e = j;
        const int rem = L - ts[e] * 8, nte = ts[e + 1] - ts[e];
        u.e = __builtin_amdgcn_readfirstlane(e); u.pn = __builtin_amdgcn_readfirstlane(rem / nte); u.mtl = __builtin_amdgcn_readfirstlane(rem % nte);
        u.mtg = __builtin_amdgcn_readfirstlane(ts[e]) + u.mtl; u.cnt = __builtin_amdgcn_readfirstlane(cn[e]); u.pm = u.mtg;
        if (kind == GK_MOE1) { u.lda2 = 2048; u.ldb2 = 2048; u.A = (const char*)WSP(unsigned char, WS_A1B);
            u.B = (const char*)WSP(unsigned char, WS_EXP1) + (size_t)u.e * 2048 * 2048 + (size_t)u.pn * 256 * 2048; }
        else { u.lda2 = 1024; u.ldb2 = 1024; u.A = (const char*)WSP(unsigned char, WS_HID) + (size_t)u.mtg * 256 * 1024;
            if (C.wave == 0) { unsigned* ctr = WSP(unsigned, WS_CTL) + CW_MT + 16 * u.mtg; unsigned sp = 0;
                while ((unsigned)__builtin_amdgcn_readfirstlane((int)__hip_atomic_load(ctr, RLX_AGENT)) < 8u) { __builtin_amdgcn_s_sleep(2); if (++sp > (1u << 22)) { if (C.lane == 0) atomicAdd(WSP(unsigned, WS_CTL) + CW_TMO, 1u); break; } }
                __builtin_amdgcn_fence(__ATOMIC_ACQUIRE, "agent"); asm volatile("s_waitcnt vmcnt(0)" ::: "memory"); }
            asm volatile("" ::: "memory"); __builtin_amdgcn_s_barrier(); asm volatile("" ::: "memory");
            u.B = (const char*)WSP(unsigned char, WS_EXP2) + (size_t)u.e * 2048 * 1024 + (size_t)u.pn * 256 * 1024; }
        return true;
    }
}
__device__ __forceinline__ unsigned a_row_off(const Ctx& C, int kind, const Unit& u, int r) {
    if (kind == GK_MOE1) { const int slot = u.mtl * 256 + r; int tok = 0; if (slot < u.cnt) tok = WSP(int, WS_LIST)[u.e * 8192 + slot] >> 1; return (unsigned)tok * 2048u; }
    return (unsigned)r * u.lda2;
}

__device__ __forceinline__ unsigned cvt_pk_bf16(float lo, float hi) { unsigned r; asm volatile("v_cvt_pk_bf16_f32 %0, %1, %2" : "=v"(r) : "v"(lo), "v"(hi)); return r; }
__device__ __forceinline__ v4u pack8(const f32x4& a, const f32x4& b) { v4u w; w.x = cvt_pk_bf16(a[0], a[1]); w.y = cvt_pk_bf16(a[2], a[3]); w.z = cvt_pk_bf16(b[0], b[1]); w.w = cvt_pk_bf16(b[2], b[3]); return w; }

__device__ __forceinline__ void epilogue(const Ctx& C, int kind, const Unit& u, f32x4 (&acc)[2][2][4][2], int wr, int wc, int fr, int fq) {
    const int r0 = wr * 64 + fr;
    const int c0 = wc * 32 + fq * 8;
    if (kind == GK_PROJ) {
#pragma unroll
        for (int ai = 0; ai < 2; ++ai)
#pragma unroll
            for (int m = 0; m < 4; ++m) { bf16* rowp = u.Cb + (size_t)(r0 + ai * 128 + m * 16) * u.ldc + c0;
#pragma unroll
                for (int bj = 0; bj < 2; ++bj) *(v4u*)(rowp + bj * 128) = pack8(acc[ai][bj][m][0], acc[ai][bj][m][1]); }
        return;
    }
    if (kind == GK_XPRE) {
#pragma unroll
        for (int ai = 0; ai < 2; ++ai)
#pragma unroll
            for (int m = 0; m < 4; ++m) { bf16* rowp = u.Cb + (size_t)(r0 + ai * 128 + m * 16) * u.ldc + c0;
#pragma unroll
                for (int bj = 0; bj < 2; ++bj) *(v4u*)(rowp + bj * 128) = pack8(acc[ai][bj][m][0], acc[ai][bj][m][1]); }
        return;
    }
    if (kind == GK_OUT) {
        const float* X = C.p.in[I_X]; bf16* H1B = WSP(bf16, WS_H1B); float* ss1 = (float*)(WSP(unsigned, WS_CTL) + CW_SS1);
#pragma unroll
        for (int ai = 0; ai < 2; ++ai)
#pragma unroll
            for (int m = 0; m < 4; ++m) { const int row = u.pm * 256 + r0 + ai * 128 + m * 16; float s = 0.f;
#pragma unroll
                for (int bj = 0; bj < 2; ++bj) { const size_t off = (size_t)row * DM + u.pn * 256 + bj * 128 + c0;
                    const f32x4 h0 = *(const f32x4*)(X + off) + acc[ai][bj][m][0], h1 = *(const f32x4*)(X + off + 4) + acc[ai][bj][m][1];
                    *(v4u*)(H1B + off) = pack8(h0, h1);
                    s += (h0[0] * h0[0] + h0[1] * h0[1]) + (h0[2] * h0[2] + h0[3] * h0[3]) + (h1[0] * h1[0] + h1[1] * h1[1]) + (h1[2] * h1[2] + h1[3] * h1[3]); }
                s += __shfl_xor(s, 16); s += __shfl_xor(s, 32);
                if (fq == 0) atomicAdd(ss1 + row, s); }
        return;
    }
    if (kind == GK_SCORE) {
        const float* ss1 = (const float*)(WSP(unsigned, WS_CTL) + CW_SS1); bf16* PB_ = WSP(bf16, WS_PBUF);
        LAS float* red = (LAS float*)(C.lds + EPI_OFF);
        float mx[2][4];
#pragma unroll
        for (int ai = 0; ai < 2; ++ai)
#pragma unroll
            for (int m = 0; m < 4; ++m) { const int rt = r0 + ai * 128 + m * 16; const int row = u.pm * 256 + rt;
                const float sc = rsqrtf(__hip_atomic_load(ss1 + row, RLX_AGENT) * (1.f / DM) + EPS) * 0.04419417382415922f; float mm = -3.0e38f;
#pragma unroll
                for (int bj = 0; bj < 2; ++bj)
#pragma unroll
                    for (int n = 0; n < 2; ++n) { acc[ai][bj][m][n] *= sc;
#pragma unroll
                        for (int j = 0; j < 4; ++j) mm = fmaxf(mm, acc[ai][bj][m][n][j]); }
                mm = fmaxf(mm, __shfl_xor(mm, 16)); mm = fmaxf(mm, __shfl_xor(mm, 32));
                if (fq == 0) red[rt * 4 + wc] = mm; }
        LDS_WAIT(); __syncthreads();
#pragma unroll
        for (int ai = 0; ai < 2; ++ai)
#pragma unroll
            for (int m = 0; m < 4; ++m) { const int rt = r0 + ai * 128 + m * 16; const f32x4 q = *(const LAS f32x4*)(red + rt * 4);
                const float mm = fmaxf(fmaxf(q[0], q[1]), fmaxf(q[2], q[3])); float s = 0.f;
#pragma unroll
                for (int bj = 0; bj < 2; ++bj)
#pragma unroll
                    for (int n = 0; n < 2; ++n)
#pragma unroll
                        for (int j = 0; j < 4; ++j) { const float e = __expf(acc[ai][bj][m][n][j] - mm); acc[ai][bj][m][n][j] = e; s += e; }
                s += __shfl_xor(s, 16); s += __shfl_xor(s, 32);
                if (fq == 0) red[1024 + rt * 4 + wc] = s; mx[ai][m] = 0.f; }
        LDS_WAIT(); __syncthreads();
#pragma unroll
        for (int ai = 0; ai < 2; ++ai)
#pragma unroll
            for (int m = 0; m < 4; ++m) { const int rt = r0 + ai * 128 + m * 16; const int row = u.pm * 256 + rt; const f32x4 q = *(const LAS f32x4*)(red + 1024 + rt * 4);
                const float inv = 1.f / ((q[0] + q[1]) + (q[2] + q[3]));
#pragma unroll
                for (int bj = 0; bj < 2; ++bj) { const f32x4 p0 = acc[ai][bj][m][0] * inv, p1 = acc[ai][bj][m][1] * inv;
                    *(v4u*)(PB_ + (size_t)row * 1024 + u.pn * 256 + bj * 128 + c0) = pack8(p0, p1); } }
        (void)mx;
        LDS_WAIT(); __syncthreads();
        return;
    }
    if (kind == GK_PV) {
        bf16* H1 = WSP(bf16, WS_H1B);
#pragma unroll
        for (int ai = 0; ai < 2; ++ai)
#pragma unroll
            for (int m = 0; m < 4; ++m) { const int row = u.pm * 256 + r0 + ai * 128 + m * 16;
#pragma unroll
                for (int bj = 0; bj < 2; ++bj) { const size_t off = (size_t)row * DM + u.pn * 256 + bj * 128 + c0;
                    const v4u t = *(const v4u*)(H1 + off);
                    const f32x4 h0 = (f32x4){bf2f(t.x & 0xffffu), bf2f(t.x >> 16), bf2f(t.y & 0xffffu), bf2f(t.y >> 16)} + acc[ai][bj][m][0], h1 = (f32x4){bf2f(t.z & 0xffffu), bf2f(t.z >> 16), bf2f(t.w & 0xffffu), bf2f(t.w >> 16)} + acc[ai][bj][m][1];
                    *(v4u*)(H1 + off) = pack8(h0, h1); } }
        return;
    }
    if (kind == GK_MOE1) {
        unsigned char* HID = WSP(unsigned char, WS_HID);
#pragma unroll
        for (int ai = 0; ai < 2; ++ai)
#pragma unroll
            for (int m = 0; m < 4; ++m) { const int rt = r0 + ai * 128 + m * 16; float h[8];
#pragma unroll
                for (int j = 0; j < 4; ++j) { h[j] = siluf_(acc[ai][0][m][0][j] * WSCALE_INV) * (acc[ai][1][m][0][j] * WSCALE_INV); h[4 + j] = siluf_(acc[ai][0][m][1][j] * WSCALE_INV) * (acc[ai][1][m][1][j] * WSCALE_INV); }
                v2u o; o.x = pk4_fp8(h[0], h[1], h[2], h[3]); o.y = pk4_fp8(h[4], h[5], h[6], h[7]);
                __hip_atomic_store((unsigned long long*)(HID + (size_t)(u.mtg * 256 + rt) * 1024 + u.pn * 128 + c0), ((unsigned long long)o.y << 32) | o.x, RLX_AGENT); }
        return;
    }
    {
        unsigned char* Y = WSP(unsigned char, WS_Y); const int* list = WSP(int, WS_LIST);
#pragma unroll
        for (int ai = 0; ai < 2; ++ai)
#pragma unroll
            for (int m = 0; m < 4; ++m) { const int rt = r0 + ai * 128 + m * 16; const int slot = u.mtl * 256 + rt;
                if (slot < u.cnt) { const int aid = list[u.e * 8192 + slot];
#pragma unroll
                    for (int bj = 0; bj < 2; ++bj) { const f32x4 a = acc[ai][bj][m][0] * WSCALE_INV, b = acc[ai][bj][m][1] * WSCALE_INV; v2u o; o.x = pk4_fp8(a[0], a[1], a[2], a[3]); o.y = pk4_fp8(b[0], b[1], b[2], b[3]);
                        *(v2u*)(Y + (size_t)aid * DM + u.pn * 256 + bj * 128 + c0) = o; } } }
    }
}

__device__ __forceinline__ void moe_tables(const Ctx& C) {
    LAS int* ts = (LAS int*)(C.lds + TBL_OFF); LAS int* cn = ts + 40;
    if (C.tid == 0) { const unsigned* cnt = WSP(unsigned, WS_CTL) + CW_CNT; int run = 0;
        for (int e = 0; e < 32; ++e) { const int c = (int)__hip_atomic_load(cnt + e * 64, RLX_AGENT); cn[e] = c; ts[e] = run; run += (c + 255) >> 8; }
        ts[32] = run; }
    LDS_WAIT(); __syncthreads();
}

constexpr int HTB = 128 * 64 * 2;
__device__ __forceinline__ int lds_byte(int r, int c) { const int st = (r >> 4) * 2 + (c >> 5), rr = r & 15, cc = c & 31, ob = rr * 64 + cc * 2; return st * 1024 + (ob ^ (((ob >> 9) & 1) << 5)); }
__device__ __forceinline__ void stage_rc(int b, int& R, int& Cc) { const int st = b / 1024, sb = b % 1024, swz = sb ^ (((sb >> 9) & 1) << 5); R = (st >> 1) * 16 + swz / 64; Cc = (st & 1) * 32 + (swz % 64) / 2; }
__device__ __forceinline__ int perm32(int rho) { const int n = rho >> 4, i = rho & 15; return 8 * (i >> 2) + 4 * n + (i & 3); }

__device__ __forceinline__ v8i mk8(bf16x8 lo, bf16x8 hi) { const v4i a = __builtin_bit_cast(v4i, lo), b = __builtin_bit_cast(v4i, hi); return __builtin_shufflevector(a, b, 0, 1, 2, 3, 4, 5, 6, 7); }
template <int KIND>
__device__ __forceinline__ void gemm_phase_fast(const Ctx& C) {
    constexpr bool GATHER = (KIND == GK_MOE1);
    constexpr bool MX = (KIND == GK_MOE1 || KIND == GK_MOE2);
    const int tid = C.tid, wid = C.wave, lane = C.lane, wr = wid >> 2, wc = wid & 3, fr = lane & 15, fq = lane >> 4;
    LAS unsigned char* lds = C.lds;
    if (KIND == GK_MOE1 || KIND == GK_MOE2) moe_tables(C);
    constexpr int K = (KIND == GK_XPRE) ? 512 : ((KIND == GK_PV || KIND == GK_MOE2) ? 1024 : 2048);
    constexpr int nt = MX ? K / 128 : K / 64;
    Unit cur, nxt; int ui = 0;
    if (!unit_next(C, KIND, 0, cur)) return;
    int Rs[2], Cs[2];
#pragma unroll
    for (int i = 0; i < 2; ++i) stage_rc(tid * 16 + i * 8192, Rs[i], Cs[i]);
    unsigned voffB[2], voffA[2];
#pragma unroll
    for (int i = 0; i < 2; ++i) { const int Rb = (Rs[i] & ~31) + perm32(Rs[i] & 31); voffB[i] = (unsigned)Rb * cur.ldb2 + (unsigned)Cs[i] * 2u; voffA[i] = (unsigned)Rs[i] * cur.lda2 + (unsigned)Cs[i] * 2u; }
    unsigned gA[2][2], gAn[2][2];
    if constexpr (GATHER) {
#pragma unroll
        for (int h = 0; h < 2; ++h)
#pragma unroll
            for (int i = 0; i < 2; ++i) { gA[h][i] = a_row_off(C, KIND, cur, h * 128 + Rs[i]) + (unsigned)Cs[i] * 2u; gAn[h][i] = gA[h][i]; }
    }
    const size_t hstepA = GATHER ? 0 : (size_t)128 * cur.lda2, hstepB = (size_t)128 * cur.ldb2;
    constexpr size_t kstep = 128;
    const unsigned ldsw = (unsigned)wid * 1024u;
    const int aoff = lds_byte(wr * 64 + fr, fq * 8), boff = lds_byte(wc * 32 + fr, fq * 8);
#define G_SA(b, h) (((b) * 2 + (h)) * HTB)
#define G_SB(b, h) ((4 + (b) * 2 + (h)) * HTB)
#define G_STAGE(bufoff, gbase, voff) do { _Pragma("unroll") for (int _i = 0; _i < 2; ++_i) \
        __builtin_amdgcn_global_load_lds((const unsigned*)((const char*)(gbase) + (voff)[_i]), (LAS unsigned*)(lds + (bufoff) + ldsw + _i * 8192), 16, 0, 0); } while (0)
#define G_STAGE_A(bufoff, ab, go, h, kb) do { if constexpr (GATHER) { G_STAGE(bufoff, (ab) + (kb), (go)[h]); } else { G_STAGE(bufoff, (ab) + (size_t)(h) * hstepA + (kb), voffA); } } while (0)
#define G_LDA(dst, b, h) do { if constexpr (MX) { _Pragma("unroll") for (int m = 0; m < 4; ++m) dst##8[m] = mk8(*(const LAS bf16x8*)(lds + G_SA(b, h) + aoff + m * 2048), *(const LAS bf16x8*)(lds + G_SA(b, h) + aoff + m * 2048 + 1024)); } \
        else { _Pragma("unroll") for (int m = 0; m < 4; ++m) _Pragma("unroll") for (int k = 0; k < 2; ++k) dst[m][k] = *(const LAS bf16x8*)(lds + G_SA(b, h) + aoff + m * 2048 + k * 1024); } } while (0)
#define G_LDB(dst, b, h) do { if constexpr (MX) { _Pragma("unroll") for (int n = 0; n < 2; ++n) dst##8[n] = mk8(*(const LAS bf16x8*)(lds + G_SB(b, h) + boff + n * 2048), *(const LAS bf16x8*)(lds + G_SB(b, h) + boff + n * 2048 + 1024)); } \
        else { _Pragma("unroll") for (int n = 0; n < 2; ++n) _Pragma("unroll") for (int k = 0; k < 2; ++k) dst[n][k] = *(const LAS bf16x8*)(lds + G_SB(b, h) + boff + n * 2048 + k * 1024); } } while (0)
#define G_MMA(ai, bj, At, Bt) do { __builtin_amdgcn_s_setprio(1); _Pragma("unroll") for (int m = 0; m < 4; ++m) _Pragma("unroll") for (int n = 0; n < 2; ++n) { \
        if constexpr (MX) { asm volatile("s_nop 1\n\tv_mfma_scale_f32_16x16x128_f8f6f4 %0, %1, %2, %0, %3, %3 op_sel_hi:[0,0,0]" : "+v"(acc[ai][bj][m][n]) : "v"(Bt##8[n]), "v"(At##8[m]), "v"(mxs)); } \
        else { _Pragma("unroll") for (int k = 0; k < 2; ++k) acc[ai][bj][m][n] = __builtin_amdgcn_mfma_f32_16x16x32_bf16(Bt[n][k], At[m][k], acc[ai][bj][m][n], 0, 0, 0); } } \
        __builtin_amdgcn_s_setprio(0); } while (0)
#define G_WAIT_V(n) asm volatile("s_waitcnt vmcnt(" #n ")" ::: "memory")
#define G_WAIT_L(n) asm volatile("s_waitcnt lgkmcnt(" #n ")" ::: "memory")
#define G_BAR __builtin_amdgcn_s_barrier()
#define G_SCHED __builtin_amdgcn_sched_barrier(0)
    f32x4 acc[2][2][4][2];
#pragma unroll
    for (int a = 0; a < 2; ++a)
#pragma unroll
        for (int b = 0; b < 2; ++b)
#pragma unroll
            for (int m = 0; m < 4; ++m)
#pragma unroll
                for (int n = 0; n < 2; ++n) acc[a][b][m][n] = (f32x4){0.f, 0.f, 0.f, 0.f};
    bf16x8 At[4][2], B0[2][2], B1[2][2];
    v8i At8[4], B08[2], B18[2];
    int mxs = 0x7f7f7f7f; asm volatile("" : "+v"(mxs));
    const char* cA = cur.A; const char* cB = cur.B;
    G_STAGE(G_SB(0, 0), cB, voffB); G_STAGE(G_SB(0, 1), cB + hstepB, voffB); G_STAGE_A(G_SA(0, 0), cA, gA, 0, 0); G_STAGE_A(G_SA(0, 1), cA, gA, 1, 0);
    if (wr == 1) G_BAR;
    G_WAIT_V(2); G_BAR;
    G_STAGE(G_SB(1, 0), cB + kstep, voffB); G_STAGE_A(G_SA(1, 0), cA, gA, 0, kstep); G_STAGE(G_SB(1, 1), cB + hstepB + kstep, voffB);
    G_WAIT_V(6); G_BAR;
    for (;;) {
        const bool has_next = unit_next(C, KIND, ui + 1, nxt);
        const char* nA = has_next ? nxt.A : cA; const char* nB = has_next ? nxt.B : cB;
        if constexpr (GATHER) { if (has_next) {
#pragma unroll
            for (int h = 0; h < 2; ++h)
#pragma unroll
                for (int i = 0; i < 2; ++i) gAn[h][i] = a_row_off(C, KIND, nxt, h * 128 + Rs[i]) + (unsigned)Cs[i] * 2u; } }
#pragma nounroll
        for (int t = 0; t < nt; t += 2) {
            const bool last = (t == nt - 2);
            const char* a2 = last ? nA : cA + (size_t)(t + 2) * kstep; const char* b2 = last ? nB : cB + (size_t)(t + 2) * kstep;
            unsigned g2[2][2];
            if constexpr (GATHER) {
#pragma unroll
                for (int h = 0; h < 2; ++h)
#pragma unroll
                    for (int i = 0; i < 2; ++i) g2[h][i] = last ? gAn[h][i] : gA[h][i]; }
            G_LDB(B0, 0, 0); G_LDB(B1, 0, 1); G_SCHED; G_LDA(At, 0, 0); G_STAGE_A(G_SA(1, 1), cA, gA, 1, (size_t)(t + 1) * kstep);
            G_WAIT_V(8); G_WAIT_L(0); G_BAR; G_MMA(0, 0, At, B0); G_MMA(0, 1, At, B1); G_BAR; G_SCHED;
            G_LDA(At, 0, 1); G_STAGE(G_SB(0, 0), b2, voffB); G_STAGE(G_SB(0, 1), b2 + hstepB, voffB); G_STAGE_A(G_SA(0, 0), a2, g2, 0, 0);
            G_WAIT_V(8); G_WAIT_L(0); G_BAR; G_MMA(1, 0, At, B0); G_MMA(1, 1, At, B1); G_BAR; G_SCHED;
            G_LDB(B0, 1, 0); G_LDB(B1, 1, 1); G_SCHED; G_LDA(At, 1, 0); G_STAGE_A(G_SA(0, 1), a2, g2, 1, 0);
            G_WAIT_V(8); G_WAIT_L(0); G_BAR; G_MMA(0, 0, At, B0); G_MMA(0, 1, At, B1); G_BAR; G_SCHED;
            G_LDA(At, 1, 1); G_STAGE(G_SB(1, 0), b2 + kstep, voffB); G_STAGE(G_SB(1, 1), b2 + kstep + hstepB, voffB); G_STAGE_A(G_SA(1, 0), a2, g2, 0, kstep);
            G_WAIT_V(8); G_WAIT_L(0); G_BAR; G_MMA(1, 0, At, B0); G_MMA(1, 1, At, B1); G_BAR; G_SCHED;
        }
        if (wr == 0) G_BAR;
        if constexpr (MX) asm volatile("s_nop 15\n\ts_nop 15" ::: "memory");
        { int te = threadIdx.x; asm volatile("" : "+v"(te));
          const int el = te & 63, ew = __builtin_amdgcn_readfirstlane(te >> 6); epilogue(C, KIND, cur, acc, ew >> 2, ew & 3, el & 15, el >> 4); }
        if constexpr (KIND == GK_MOE1) {
            G_WAIT_V(0); G_BAR;
            if (tid == 0) __hip_atomic_fetch_add(WSP(unsigned, WS_CTL) + CW_MT + 16 * cur.mtg, 1u, RLX_AGENT); }
        if (!has_next) break;
#pragma unroll
        for (int a = 0; a < 2; ++a)
#pragma unroll
            for (int b = 0; b < 2; ++b)
#pragma unroll
                for (int m = 0; m < 4; ++m)
#pragma unroll
                    for (int n = 0; n < 2; ++n) acc[a][b][m][n] = (f32x4){0.f, 0.f, 0.f, 0.f};
        cur = nxt; cA = nA; cB = nB; ++ui;
        if constexpr (GATHER) {
#pragma unroll
            for (int h = 0; h < 2; ++h)
#pragma unroll
                for (int i = 0; i < 2; ++i) gA[h][i] = gAn[h][i]; }
        if (wr == 1) G_BAR;
    }
    G_WAIT_V(0);
    G_BAR;
#undef G_SA
#undef G_SB
#undef G_STAGE
#undef G_STAGE_A
#undef G_LDA
#undef G_LDB
#undef G_MMA
#undef G_WAIT_V
#undef G_WAIT_L
#undef G_BAR
#undef G_SCHED
}

__device__ __forceinline__ void la_phase_scan(const Ctx& C) {
    const int g = blockIdx.x * 512 + C.tid;
    bf16* base; const float* db; size_t cstride, dstride;
    if (g < 65536) { const int d4 = g & 31, v = (g >> 5) & 255, h = (g >> 13) & 3, b = g >> 15;
        base = WSP(bf16, WS_UT) + ((size_t)(b * 64 * 4 + h) * 256 + v) * 128 + d4 * 4; cstride = (size_t)4 * 256 * 128;
        db = WSP(float, WS_DB) + (size_t)(b * 64 * 4 + h) * 128 + d4 * 4; dstride = 4 * 128; }
    else { const int g2 = g - 65536; const int d4 = g2 & 31, v = (g2 >> 5) & 127, h = (g2 >> 12) & 7, b = g2 >> 15;
        base = WSP(bf16, WS_UT) + (size_t)128 * 4 * 256 * 128 + ((size_t)(b * 64 * 8 + h) * 128 + v) * 128 + d4 * 4; cstride = (size_t)8 * 128 * 128;
        db = WSP(float, WS_DB) + 128 * 4 * 128 + (size_t)(b * 64 * 8 + h) * 128 + d4 * 4; dstride = 8 * 128; }
    float S[4] = {0.f, 0.f, 0.f, 0.f};
    for (int c0 = 0; c0 < 64; c0 += 8) {
        v2u uu[8]; f32x4 dd[8];
#pragma unroll
        for (int j = 0; j < 8; ++j) { uu[j] = *(const v2u*)(base + (size_t)(c0 + j) * cstride); dd[j] = *(const f32x4*)(db + (size_t)(c0 + j) * dstride); }
#pragma unroll
        for (int j = 0; j < 8; ++j) { v2u o; o.x = pk2(S[0], S[1]); o.y = pk2(S[2], S[3]); *(v2u*)(base + (size_t)(c0 + j) * cstride) = o;
            S[0] = dd[j][0] * S[0] + bf2f(uu[j].x & 0xffffu); S[1] = dd[j][1] * S[1] + bf2f(uu[j].x >> 16);
            S[2] = dd[j][2] * S[2] + bf2f(uu[j].y & 0xffffu); S[3] = dd[j][3] * S[3] + bf2f(uu[j].y >> 16); }
    }
}
__device__ __forceinline__ bf16x8 ld_frag(const LAS unsigned char* base, int stride, int row0, int ks, int lane) {
    return *(const LAS bf16x8*)(base + (row0 + (lane & 15)) * stride + (32 * ks + 8 * (lane >> 4)) * 2);
}
template <int DV>
__device__ __forceinline__ void load_vT_regs(const Ctx& C, const bf16* vsrc  , v4u (&r)[DV / 64]) {
    const int lane = C.lane, tl = lane & 15, v8l = lane >> 4;
#pragma unroll
    for (int it = 0; it < DV / 64; ++it) { const int blk = C.wave * (DV / 64) + it; const int tb = blk & 3, vb = blk >> 2; const int t = tb * 16 + tl, v8 = vb * 4 + v8l;
        r[it] = *(const v4u*)(vsrc + (size_t)t * NPROJ + v8 * 8); }
}
template <int DV>
__device__ __forceinline__ void store_vT_regs(const Ctx& C, LAS unsigned char* VR, const v4u (&r)[DV / 64]) {
    const int lane = C.lane, tl = lane & 15, v8l = lane >> 4;
#pragma unroll
    for (int it = 0; it < DV / 64; ++it) { const int blk = C.wave * (DV / 64) + it; const int tb = blk & 3, vb = blk >> 2; const int t = tb * 16 + tl, v8 = vb * 4 + v8l;
        *(LAS v4u*)(VR + t * (DV * 2 + 16) + v8 * 16) = r[it]; }
}
typedef short v4s __attribute__((ext_vector_type(4)));
template <int DV>
__device__ __forceinline__ bf16x8 ld_frag_tr(const LAS unsigned char* VR, int v0, int ks, int lane) {
    const int g = lane >> 4, i = lane & 15, q = i >> 2, p = i & 3;
    const LAS unsigned char* a0 = VR + (32 * ks + 8 * g + q) * (DV * 2 + 16) + (v0 + 4 * p) * 2;
    const v4s lo = __builtin_amdgcn_ds_read_tr16_b64_v4i16((LAS v4s*)a0), hi = __builtin_amdgcn_ds_read_tr16_b64_v4i16((LAS v4s*)(a0 + 4 * (DV * 2 + 16)));
    return (bf16x8){lo[0], lo[1], lo[2], lo[3], hi[0], hi[1], hi[2], hi[3]};
}
template <int DV> struct PaRegs { v4u vr[DV / 64]; unsigned gt[16], qv[16], kv[16]; };
template <int DV, bool GLA>
__device__ __forceinline__ void pa_load(const Ctx& C, int bc, int h, PaRegs<DV>& R) {
    const int tid = C.tid, d = tid & 127, sg = tid >> 7; const int t0 = bc * 64;
    const bf16* PB = WSP(bf16, WS_PB);
    const int qcol = (GLA ? C_GQ : C_HQ) + h * 128, kcol = (GLA ? C_GK : C_HK) + h * 128, vcol = (GLA ? C_GV : C_HV) + h * DV;
    load_vT_regs<DV>(C, PB + (size_t)t0 * NPROJ + vcol, R.vr);
    const bf16* gp = PB + (size_t)(t0 + sg * 16) * NPROJ + (GLA ? C_GA : C_HK) + h * 128 + d;
    const bf16* pq = PB + (size_t)(t0 + sg * 16) * NPROJ + qcol + d; const bf16* pk = PB + (size_t)(t0 + sg * 16) * NPROJ + kcol + d;
#pragma unroll
    for (int i = 0; i < 16; ++i) { R.gt[i] = __builtin_nontemporal_load(gp + (size_t)i * NPROJ); R.qv[i] = __builtin_nontemporal_load(pq + (size_t)i * NPROJ); if (GLA) R.kv[i] = __builtin_nontemporal_load(pk + (size_t)i * NPROJ); }
}
template <int DV, bool GLA>
__device__ __forceinline__ void pa_part1(const Ctx& C, int bc, int h, const PaRegs<DV>& R) {
    const int tid = C.tid, d = tid & 127, sg = tid >> 7;
    LAS unsigned char* kT = C.lds;
    LAS unsigned char* VT = C.lds + 18432;
    LAS float* seg = (LAS float*)(C.lds + 18432 + 36864);
    LAS float* Dl  = seg + 512;
    const int t0 = bc * 64;
    bf16* PB = WSP(bf16, WS_PB);
    const int qcol = (GLA ? C_GQ : C_HQ) + h * 128, kcol = (GLA ? C_GK : C_HK) + h * 128;
    constexpr float qscale = GLA ? 0.08838834764831845f : 1.0f;
    store_vT_regs<DV>(C, VT, R.vr);
    float gt[16], qf[16], kf[16];
    { float lb = 0.f, ba = 0.f; if (GLA) ba = C.p.in[I_BALPHA][h * 128 + d]; if (!GLA) { const float* lg = C.p.in[I_LBLOG]; lb = 1.f / (1.f + __expf(lg[1024 + h * 128 + d] - lg[h * 128 + d])); }
#pragma unroll
      for (int i = 0; i < 16; ++i) { const float q = bf2f(R.qv[i]);
          if (GLA) { gt[i] = logsigmoidf_(bf2f(R.gt[i]) + ba) * 0.0625f; qf[i] = q; kf[i] = bf2f(R.kv[i]); }
          else { const float z = fminf(fmaxf(bf2f(R.gt[i]), -30.f), 30.f), ez = __expf(-z), sg = 1.f / (1.f + ez);
                 gt[i] = __logf(lb + (1.f - lb) * sg); kf[i] = (1.f - lb) * ez * sg; qf[i] = siluf_(q); } } }
    float run = 0.f;
#pragma unroll
    for (int i = 0; i < 16; ++i) run += gt[i];
    seg[sg * 128 + d] = run;
    LDS_WAIT(); __syncthreads();
    float b = 0.f;
    for (int s = 0; s < sg; ++s) b += seg[s * 128 + d];
    { bf16* pq = PB + (size_t)(t0 + sg * 16) * NPROJ + qcol + d; bf16* pk = PB + (size_t)(t0 + sg * 16) * NPROJ + kcol + d;
#pragma unroll
      for (int hh = 0; hh < 2; ++hh) { unsigned kk[8];
#pragma unroll
        for (int i = 0; i < 8; ++i) {
            b += gt[hh * 8 + i];
            const unsigned qt = f2bf(qf[hh * 8 + i] * qscale * __expf(b)), kt = f2bf(kf[hh * 8 + i] * __expf(-b));
            pq[(size_t)(hh * 8 + i) * NPROJ] = (bf16)qt; pk[(size_t)(hh * 8 + i) * NPROJ] = (bf16)kt; kk[i] = kt; }
        v4u w; w.x = kk[0] | (kk[1] << 16); w.y = kk[2] | (kk[3] << 16); w.z = kk[4] | (kk[5] << 16); w.w = kk[6] | (kk[7] << 16);
        *(LAS v4u*)(kT + d * 144 + (sg * 16 + hh * 8) * 2) = w; }
      if (sg == 3) { const float dd = __expf(b); Dl[d] = dd; (GLA ? WSP(float, WS_DB) + (size_t)(bc * 4 + h) * 128 : WSP(float, WS_DB) + 128 * 4 * 128 + (size_t)(bc * 8 + h) * 128)[d] = dd; } }
}
template <int DV, bool GLA>
__device__ __forceinline__ void pa_part2(const Ctx& C, int bc, int h) {
    const int lane = C.lane;
    LAS unsigned char* kT = C.lds; LAS unsigned char* VT = C.lds + 18432; LAS float* Dl = (LAS float*)(C.lds + 18432 + 36864) + 512;
    LDS_WAIT(); __syncthreads();
    { const int dt = C.wave; bf16* UT = GLA ? WSP(bf16, WS_UT) + (size_t)(bc * 4 + h) * 256 * 128 : WSP(bf16, WS_UT) + (size_t)128 * 4 * 256 * 128 + (size_t)(bc * 8 + h) * 128 * 128;
      const bf16x8 k0 = ld_frag(kT, 144, dt * 16, 0, lane), k1 = ld_frag(kT, 144, dt * 16, 1, lane);
      const f32x4 dd = *(const LAS f32x4*)(Dl + dt * 16 + 4 * (lane >> 4));
      for (int v4 = 0; v4 < DV / 64; ++v4) { bf16x8 f0[4], f1[4]; f32x4 acc[4];
#pragma unroll
          for (int j = 0; j < 4; ++j) { f0[j] = ld_frag_tr<DV>(VT, (v4 * 4 + j) * 16, 0, lane); f1[j] = ld_frag_tr<DV>(VT, (v4 * 4 + j) * 16, 1, lane); }
#pragma unroll
          for (int j = 0; j < 4; ++j) acc[j] = __builtin_amdgcn_mfma_f32_16x16x32_bf16(k0, f0[j], (f32x4){0.f, 0.f, 0.f, 0.f}, 0, 0, 0);
#pragma unroll
          for (int j = 0; j < 4; ++j) acc[j] = __builtin_amdgcn_mfma_f32_16x16x32_bf16(k1, f1[j], acc[j], 0, 0, 0);
#pragma unroll
          for (int j = 0; j < 4; ++j) { v2u o; o.x = pk2(acc[j][0] * dd[0], acc[j][1] * dd[1]); o.y = pk2(acc[j][2] * dd[2], acc[j][3] * dd[3]);
              *(v2u*)(UT + (size_t)((v4 * 4 + j) * 16 + (lane & 15)) * 128 + dt * 16 + 4 * (lane >> 4)) = o; } } }
    LDS_WAIT(); __syncthreads();
}
__device__ __forceinline__ void la2_phase_a(const Ctx& C) {
    const int w = blockIdx.x, bc = w >> 1, half = w & 1;
    PaRegs<256> g0, g1; PaRegs<128> h0, h1, h2, h3;
#define SB_ __builtin_amdgcn_sched_barrier(0)
    pa_load<256, true>(C, bc, half * 2 + 0, g0); SB_;
    pa_load<256, true>(C, bc, half * 2 + 1, g1); SB_; pa_part1<256, true>(C, bc, half * 2 + 0, g0); pa_part2<256, true>(C, bc, half * 2 + 0); SB_;
    pa_load<128, false>(C, bc, half * 4 + 0, h0); SB_; pa_part1<256, true>(C, bc, half * 2 + 1, g1); pa_part2<256, true>(C, bc, half * 2 + 1); SB_;
    pa_load<128, false>(C, bc, half * 4 + 1, h1); SB_; pa_part1<128, false>(C, bc, half * 4 + 0, h0); pa_part2<128, false>(C, bc, half * 4 + 0); SB_;
    pa_load<128, false>(C, bc, half * 4 + 2, h2); SB_; pa_part1<128, false>(C, bc, half * 4 + 1, h1); pa_part2<128, false>(C, bc, half * 4 + 1); SB_;
    pa_load<128, false>(C, bc, half * 4 + 3, h3); SB_; pa_part1<128, false>(C, bc, half * 4 + 2, h2); pa_part2<128, false>(C, bc, half * 4 + 2); SB_;
    pa_part1<128, false>(C, bc, half * 4 + 3, h3); pa_part2<128, false>(C, bc, half * 4 + 3);
#undef SB_
}
template <int DV> struct PcRegs { v4u qr[2], kr[2], sr[DV / 32], vr[DV / 64]; };
template <int DV, bool GLA>
__device__ __forceinline__ void pc_load(const Ctx& C, int bc, int h, PcRegs<DV>& R) {
    const int tid = C.tid; const int t0 = bc * 64; const bf16* PB = WSP(bf16, WS_PB);
    const int qcol = (GLA ? C_GQ : C_HQ) + h * 128, kcol = (GLA ? C_GK : C_HK) + h * 128, vcol = (GLA ? C_GV : C_HV) + h * DV;
    const bf16* ST = GLA ? WSP(bf16, WS_UT) + (size_t)(bc * 4 + h) * 256 * 128 : WSP(bf16, WS_UT) + (size_t)128 * 4 * 256 * 128 + (size_t)(bc * 8 + h) * 128 * 128;
#pragma unroll
    for (int it = 0; it < 2; ++it) { const int idx = tid + it * 512; const int t = idx >> 4, c8 = idx & 15;
        R.qr[it] = __builtin_nontemporal_load((const v4u*)(PB + (size_t)(t0 + t) * NPROJ + qcol + c8 * 8)); R.kr[it] = __builtin_nontemporal_load((const v4u*)(PB + (size_t)(t0 + t) * NPROJ + kcol + c8 * 8)); }
#pragma unroll
    for (int it = 0; it < DV / 32; ++it) { const int idx = tid + it * 512; const int v = idx >> 4, c8 = idx & 15; R.sr[it] = __builtin_nontemporal_load((const v4u*)(ST + (size_t)v * 128 + c8 * 8)); }
    load_vT_regs<DV>(C, PB + (size_t)t0 * NPROJ + vcol, R.vr);
}
template <int DV, bool GLA>
__device__ __forceinline__ void pc_part1(const Ctx& C, const PcRegs<DV>& R) {
    const int tid = C.tid;
    LAS unsigned char* qL = C.lds; LAS unsigned char* kL = C.lds + 17408; LAS unsigned char* VT = C.lds + 34816; LAS unsigned char* sL = C.lds + 34816 + 36864;
#pragma unroll
    for (int it = 0; it < 2; ++it) { const int idx = tid + it * 512; const int t = idx >> 4, c8 = idx & 15;
        *(LAS v4u*)(qL + t * 272 + c8 * 16) = R.qr[it]; *(LAS v4u*)(kL + t * 272 + c8 * 16) = R.kr[it]; }
#pragma unroll
    for (int it = 0; it < DV / 32; ++it) { const int idx = tid + it * 512; const int v = idx >> 4, c8 = idx & 15; *(LAS v4u*)(sL + v * 272 + c8 * 16) = R.sr[it]; }
    store_vT_regs<DV>(C, VT, R.vr);
}
template <int DV, bool GLA>
__device__ __forceinline__ void pc_part2(const Ctx& C, int bc, int h) {
    const int lane = C.lane, w = C.wave;
    LAS unsigned char* qL = C.lds;
    LAS unsigned char* kL = C.lds + 17408;
    LAS unsigned char* VT = C.lds + 34816;
    LAS unsigned char* sL = C.lds + 34816 + 36864;
    LAS unsigned char* AL = C.lds + 71680 + 69632;
    LAS float* red = (LAS float*)(C.lds + 141312 + 9216);
    const int t0 = bc * 64;
    const bf16* PB = WSP(bf16, WS_PB);
    const int gcol = (GLA ? C_GG : C_HG) + h * DV;
    LDS_WAIT(); __syncthreads();
    { const int it = w & 3, jt0 = (w >> 2) * 2; f32x4 a2[2] = {{0.f, 0.f, 0.f, 0.f}, {0.f, 0.f, 0.f, 0.f}};
      if (jt0 <= it) {
#pragma unroll
          for (int ks = 0; ks < 4; ++ks) { const bf16x8 qf = ld_frag(qL, 272, it * 16, ks, lane), k0 = ld_frag(kL, 272, jt0 * 16, ks, lane), k1 = ld_frag(kL, 272, jt0 * 16 + 16, ks, lane);
              a2[0] = __builtin_amdgcn_mfma_f32_16x16x32_bf16(k0, qf, a2[0], 0, 0, 0); a2[1] = __builtin_amdgcn_mfma_f32_16x16x32_bf16(k1, qf, a2[1], 0, 0, 0); } }
#pragma unroll
      for (int jj = 0; jj < 2; ++jj) { const int jt = jt0 + jj; const f32x4 acc = a2[jj];
          const int i = it * 16 + (lane & 15), j0 = jt * 16 + 4 * (lane >> 4);
          v2u o; o.x = pk2(j0 + 0 <= i ? acc[0] : 0.f, j0 + 1 <= i ? acc[1] : 0.f); o.y = pk2(j0 + 2 <= i ? acc[2] : 0.f, j0 + 3 <= i ? acc[3] : 0.f);
          *(LAS v2u*)(AL + i * 144 + j0 * 2) = o; } }
    LDS_WAIT(); __syncthreads();
    constexpr int NV = DV / 32;
    const int tt = w & 3, vh = w >> 2;
    f32x4 o[NV];
    { bf16x8 af[2], qf[4];
#pragma unroll
      for (int ks = 0; ks < 2; ++ks) af[ks] = ld_frag(AL, 144, tt * 16, ks, lane);
#pragma unroll
      for (int ks = 0; ks < 4; ++ks) qf[ks] = ld_frag(qL, 272, tt * 16, ks, lane);
#pragma unroll
      for (int n = 0; n < NV; ++n) o[n] = (f32x4){0.f, 0.f, 0.f, 0.f};
#pragma unroll
      for (int ks = 0; ks < 2; ++ks) { bf16x8 vf[NV];
#pragma unroll
          for (int n = 0; n < NV; ++n) vf[n] = ld_frag_tr<DV>(VT, (vh * NV + n) * 16, ks, lane);
#pragma unroll
          for (int n = 0; n < NV; ++n) o[n] = __builtin_amdgcn_mfma_f32_16x16x32_bf16(vf[n], af[ks], o[n], 0, 0, 0); }
#pragma unroll
      for (int ks = 0; ks < 4; ++ks) { bf16x8 sf[NV];
#pragma unroll
          for (int n = 0; n < NV; ++n) sf[n] = ld_frag(sL, 272, (vh * NV + n) * 16, ks, lane);
#pragma unroll
          for (int n = 0; n < NV; ++n) o[n] = __builtin_amdgcn_mfma_f32_16x16x32_bf16(sf[n], qf[ks], o[n], 0, 0, 0); } }
    { float s = 0.f;
#pragma unroll
      for (int n = 0; n < NV; ++n) s += (o[n][0] * o[n][0] + o[n][1] * o[n][1]) + (o[n][2] * o[n][2] + o[n][3] * o[n][3]);
      s += __shfl_xor(s, 16); s += __shfl_xor(s, 32);
      if (lane < 16) red[(tt * 16 + lane) * 2 + vh] = s; }
    LDS_WAIT(); __syncthreads();
    { const int t = tt * 16 + (lane & 15); const f32x2 rr = *(const LAS f32x2*)(red + t * 2); const float rstd = rsqrtf((rr[0] + rr[1]) * (1.f / DV) + EPS);
      const float* gn = GLA ? C.p.in[I_GLAG] : C.p.in[I_HGRNG]; bf16* ON = WSP(bf16, WS_ON); const int ocol = GLA ? h * 256 : 1024 + h * 128;
#pragma unroll
      for (int n = 0; n < NV; ++n) { const int v0 = (vh * NV + n) * 16 + 4 * (lane >> 4); const f32x4 g4 = *(const f32x4*)(gn + v0);
          const v2u gt = *(const v2u*)(PB + (size_t)(t0 + t) * NPROJ + gcol + v0);
          v2u ow; ow.x = pk2(o[n][0] * rstd * g4[0] * siluf_(bf2f(gt.x & 0xffffu)), o[n][1] * rstd * g4[1] * siluf_(bf2f(gt.x >> 16)));
          ow.y = pk2(o[n][2] * rstd * g4[2] * siluf_(bf2f(gt.y & 0xffffu)), o[n][3] * rstd * g4[3] * siluf_(bf2f(gt.y >> 16)));
          *(v2u*)(ON + (size_t)(t0 + t) * DM + ocol + v0) = ow; } }
    LDS_WAIT(); __syncthreads();
}
__device__ __forceinline__ void la2_phase_c(const Ctx& C) {
    const int w = blockIdx.x, bc = w >> 1, half = w & 1;
    PcRegs<256> g0, g1; PcRegs<128> h0, h1, h2, h3;
#define SB_ __builtin_amdgcn_sched_barrier(0)
    pc_load<256, true>(C, bc, half * 2 + 0, g0); SB_;
    pc_load<256, true>(C, bc, half * 2 + 1, g1); SB_; pc_part1<256, true>(C, g0); pc_part2<256, true>(C, bc, half * 2 + 0); SB_;
    pc_load<128, false>(C, bc, half * 4 + 0, h0); SB_; pc_part1<256, true>(C, g1); pc_part2<256, true>(C, bc, half * 2 + 1); SB_;
    pc_load<128, false>(C, bc, half * 4 + 1, h1); SB_; pc_part1<128, false>(C, h0); pc_part2<128, false>(C, bc, half * 4 + 0); SB_;
    pc_load<128, false>(C, bc, half * 4 + 2, h2); SB_; pc_part1<128, false>(C, h1); pc_part2<128, false>(C, bc, half * 4 + 1); SB_;
    pc_load<128, false>(C, bc, half * 4 + 3, h3); SB_; pc_part1<128, false>(C, h2); pc_part2<128, false>(C, bc, half * 4 + 2); SB_;
    pc_part1<128, false>(C, h3); pc_part2<128, false>(C, bc, half * 4 + 3);
#undef SB_
}

__device__ __forceinline__ void router_phase(const Ctx& C) {
    const int r0 = blockIdx.x * 32, lane = C.lane, w = C.wave;
    LAS float* rs = (LAS float*)C.lds;
    LAS float* part = (LAS float*)(C.lds + 256);
    const bf16* H2 = WSP(bf16, WS_H1B); const float* g3 = C.p.in[I_NFFNG]; unsigned char* A3F = WSP(unsigned char, WS_A1B);
    for (int j = 0; j < 4; ++j) { const int row = r0 + w * 4 + j;
        const v2u* xr = (const v2u*)(H2 + (size_t)row * DM) + lane; const f32x4* gr = (const f32x4*)g3 + lane; f32x4 v[8]; float s = 0.f; v2u tb[8];
#pragma unroll
        for (int q = 0; q < 8; ++q) tb[q] = xr[64 * q];
#pragma unroll
        for (int q = 0; q < 8; ++q) { v[q] = (f32x4){bf2f(tb[q].x & 0xffffu), bf2f(tb[q].x >> 16), bf2f(tb[q].y & 0xffffu), bf2f(tb[q].y >> 16)}; s += (v[q].x * v[q].x + v[q].y * v[q].y) + (v[q].z * v[q].z + v[q].w * v[q].w); }
        const float rstd = rsqrtf(wave_sum(s) * (1.f / DM) + EPS);
        if (lane == 0) rs[w * 4 + j] = rstd;
        unsigned* o4 = (unsigned*)(A3F + (size_t)row * DM) + lane;
#pragma unroll
        for (int q = 0; q < 8; ++q) { const f32x4 gg = gr[64 * q]; o4[64 * q] = pk4_fp8(v[q].x * rstd * gg.x, v[q].y * rstd * gg.y, v[q].z * rstd * gg.z, v[q].w * rstd * gg.w); } }
    { const int rt = w & 1, kq = w >> 1, ar = lane & 15, kg = lane >> 4; const float* WRT = WSP(float, WS_WRT);
      f32x4 a0 = {0.f, 0.f, 0.f, 0.f}, a1 = a0, a2 = a0;
      const bf16* hp = H2 + (size_t)(r0 + rt * 16 + ar) * DM + kq * 512 + kg * 4; const float* wp = WRT + (size_t)ar * DM + kq * 512 + kg * 4;
      v2u a4b = *(const v2u*)(hp); f32x4 b0 = *(const f32x4*)(wp), b1 = *(const f32x4*)(wp + 16 * DM), b2 = *(const f32x4*)(wp + 32 * DM);
#pragma unroll 2
      for (int s = 0; s < 32; ++s) { const int sn = (s + 1) & 31;
          const v2u na = *(const v2u*)(hp + sn * 16); const f32x4 a4 = {bf2f(a4b.x & 0xffffu), bf2f(a4b.x >> 16), bf2f(a4b.y & 0xffffu), bf2f(a4b.y >> 16)}; const f32x4 n0 = *(const f32x4*)(wp + sn * 16), n1 = *(const f32x4*)(wp + 16 * DM + sn * 16), n2 = *(const f32x4*)(wp + 32 * DM + sn * 16);
#pragma unroll
          for (int i = 0; i < 4; ++i) { a0 = __builtin_amdgcn_mfma_f32_16x16x4f32(a4[i], b0[i], a0, 0, 0, 0); a1 = __builtin_amdgcn_mfma_f32_16x16x4f32(a4[i], b1[i], a1, 0, 0, 0); a2 = __builtin_amdgcn_mfma_f32_16x16x4f32(a4[i], b2[i], a2, 0, 0, 0); }
          a4b = na; b0 = n0; b1 = n1; b2 = n2; }
#pragma unroll
      for (int rg = 0; rg < 4; ++rg) { LAS float* pr = part + (kq * 32 + rt * 16 + 4 * kg + rg) * 48 + ar; pr[0] = a0[rg]; pr[16] = a1[rg]; pr[32] = a2[rg]; } }
    LDS_WAIT(); __syncthreads();
    LAS float* lgL = part + 4 * 32 * 48;
    for (int idx = C.tid; idx < 32 * 48; idx += 512) { const int t = idx / 48, c = idx % 48;
        lgL[idx] = ((part[(0 * 32 + t) * 48 + c] + part[(1 * 32 + t) * 48 + c]) + (part[(2 * 32 + t) * 48 + c] + part[(3 * 32 + t) * 48 + c])) * rs[t]; }
    LDS_WAIT(); __syncthreads();
    if (C.tid < 32) { const int t = C.tid, row = r0 + t; const LAS float* lg = lgL + t * 48;
        const float* brg = C.p.in[I_BRG]; const float* bre = C.p.in[I_BRE];
        int grp = 0; float gm = -3.0e38f;
        for (int g = 0; g < 4; ++g) { const float x = lg[32 + g] + brg[g]; if (x > gm) { gm = x; grp = g; } }
        float gs = 0.f; for (int g = 0; g < 4; ++g) gs += __expf(lg[32 + g] + brg[g] - gm);
        const float pg = 1.f / gs;
        float v1 = -3.0e38f, v2 = -3.0e38f; int i1 = 0, i2 = 0;
        for (int j = 0; j < 8; ++j) { const float x = lg[grp * 8 + j] + bre[grp * 8 + j];
            if (x > v1) { v2 = v1; i2 = i1; v1 = x; i1 = j; } else if (x > v2) { v2 = x; i2 = j; } }
        const float e2 = __expf(v2 - v1); const float w1 = pg / (1.f + e2), w2 = pg * e2 / (1.f + e2);
        unsigned* cnt = WSP(unsigned, WS_CTL) + CW_CNT; int* list = WSP(int, WS_LIST); float* gw = WSP(float, WS_GATEW);
        const int ea = grp * 8 + i1, eb = grp * 8 + i2;
        const unsigned pa = atomicAdd(cnt + ea * 64, 1u); list[ea * 8192 + pa] = row * 2; gw[row * 2] = w1;
        const unsigned pb = atomicAdd(cnt + eb * 64, 1u); list[eb * 8192 + pb] = row * 2 + 1; gw[row * 2 + 1] = w2; }
}

__device__ __forceinline__ void final_phase(const Ctx& C) {
    const int lane = C.lane; const bf16* H2 = WSP(bf16, WS_H1B); const unsigned char* Y = WSP(unsigned char, WS_Y); const float* gw = WSP(float, WS_GATEW); const float* gf = C.p.in[I_NFING];
    for (int j = 0; j < 4; ++j) { const int row = blockIdx.x * 32 + C.wave * 4 + j; const float w0 = gw[row * 2], w1 = gw[row * 2 + 1];
        const v2u* xr = (const v2u*)(H2 + (size_t)row * DM) + lane; const unsigned* y0 = (const unsigned*)(Y + (size_t)(row * 2) * DM) + lane; const unsigned* y1 = (const unsigned*)(Y + (size_t)(row * 2 + 1) * DM) + lane;
        f32x4 v[8]; float s = 0.f;
#pragma unroll
        for (int q = 0; q < 8; ++q) { const unsigned a = __builtin_nontemporal_load(y0 + 64 * q), b = __builtin_nontemporal_load(y1 + 64 * q); const v2u tb = __builtin_nontemporal_load(xr + 64 * q); f32x4 x = {bf2f(tb.x & 0xffffu), bf2f(tb.x >> 16), bf2f(tb.y & 0xffffu), bf2f(tb.y >> 16)};
            const f32x2 a01 = __builtin_amdgcn_cvt_pk_f32_fp8((int)a, false), a23 = __builtin_amdgcn_cvt_pk_f32_fp8((int)a, true), b01 = __builtin_amdgcn_cvt_pk_f32_fp8((int)b, false), b23 = __builtin_amdgcn_cvt_pk_f32_fp8((int)b, true);
            x.x += w0 * a01[0] + w1 * b01[0]; x.y += w0 * a01[1] + w1 * b01[1]; x.z += w0 * a23[0] + w1 * b23[0]; x.w += w0 * a23[1] + w1 * b23[1];
            v[q] = x; s += (x.x * x.x + x.y * x.y) + (x.z * x.z + x.w * x.w); }
        const float rstd = rsqrtf(wave_sum(s) * (1.f / DM) + EPS);
        f32x4* o = (f32x4*)(C.p.out + (size_t)row * DM) + lane; const f32x4* gr = (const f32x4*)gf + lane;
#pragma unroll
        for (int q = 0; q < 8; ++q) __builtin_nontemporal_store(v[q] * rstd * gr[64 * q], o + 64 * q); }
}

constexpr int N_PHASES = 12;
__global__ void __launch_bounds__(512, 2) mk_fwd(Params p) {
    extern __shared__ __attribute__((aligned(16))) unsigned char lds_raw[];
    Ctx C; C.p = p; C.lds = (LAS unsigned char*)lds_raw; C.tid = threadIdx.x; C.lane = C.tid & 63; C.wave = __builtin_amdgcn_readfirstlane(C.tid >> 6);
    C.G = gridDim.x; { const int bx = blockIdx.x; C.vcu = (C.G % 8 == 0) ? (bx % 8) * (C.G / 8) + bx / 8 : bx; }
    volatile LAS unsigned* MISC = (volatile LAS unsigned*)(C.lds + MISC_OFF);
    const int lo = p.ph_lo, hi = p.ph_hi;
    const bool multi = (hi - lo) > 1;
    XcdBarrier bar; bar.bar = WSP(unsigned, WS_CTL) + CW_BAR; bar.x = 0; bar.st = MISC;
    if (multi) { if (C.tid < 64) MISC[C.tid] = 0u; __syncthreads(); bar = xcd_barrier_post(WSP(unsigned, WS_CTL) + CW_BAR, MISC); }
#define PHASE_BEGIN(k) if (lo <= (k) && (k) < hi) { { int t_ = threadIdx.x; asm volatile("" : "+v"(t_)); C.tid = t_; C.lane = t_ & 63; C.wave = __builtin_amdgcn_readfirstlane(t_ >> 6); \
        }
#define PHASE_END(k) if ((k) + 1 < hi) xcd_barrier(bar); }
#define GEMM_PHASE(kind) gemm_phase_fast<kind>(C)
    PHASE_BEGIN(0) p0_prologue(C); PHASE_END(0)
    PHASE_BEGIN(1) GEMM_PHASE(GK_PROJ); if (blockIdx.x >= 224) convert_expert_items(C, 0, NX_P1, (blockIdx.x - 224) * 8 + C.wave, 32 * 8); PHASE_END(1)
    PHASE_BEGIN(2) la2_phase_a(C); PHASE_END(2)
    PHASE_BEGIN(3) la_phase_scan(C); GEMM_PHASE(GK_XPRE); if (blockIdx.x >= 128) convert_expert_items(C, NX_P1, NX_P1 + NX_XPRE, (blockIdx.x - 128) * 8 + C.wave, 128 * 8); PHASE_END(3)
    PHASE_BEGIN(4) la2_phase_c(C); PHASE_END(4)
    PHASE_BEGIN(5) GEMM_PHASE(GK_OUT); PHASE_END(5)
    PHASE_BEGIN(6) GEMM_PHASE(GK_SCORE); if (blockIdx.x >= 128) convert_expert_items(C, NX_P1 + NX_XPRE, NX_DEFER, (blockIdx.x - 128) * 8 + C.wave, 128 * 8); PHASE_END(6)
    PHASE_BEGIN(7) GEMM_PHASE(GK_PV); PHASE_END(7)
    PHASE_BEGIN(8) if (blockIdx.x & 8) { convert_expert_items(C, NX_DEFER, NX_TOTAL, C.vcu * 8 + C.wave, C.G * 8); __syncthreads(); router_phase(C); } else { router_phase(C); __syncthreads(); convert_expert_items(C, NX_DEFER, NX_TOTAL, C.vcu * 8 + C.wave, C.G * 8); } PHASE_END(8)
    PHASE_BEGIN(9) GEMM_PHASE(GK_MOE1); GEMM_PHASE(GK_MOE2); PHASE_END(9)
    PHASE_BEGIN(11) final_phase(C); PHASE_END(11)
}

extern "C" void kernel_launch(void* const* d_in, const int* in_sizes, int n_in, void* d_out, int out_size, void* d_ws, size_t ws_size, hipStream_t stream) {
    static int grid = 0;
    if (grid == 0) {
        if (n_in != 24 || out_size != MTOK * DM || ws_size < WS_END) { fprintf(stderr, "kernel_launch: unexpected shapes (n_in %d out %d ws %zu need %zu)\n", n_in, out_size, ws_size, (size_t)WS_END); grid = -1; return; }
        if (hipFuncSetAttribute((const void*)mk_fwd, hipFuncAttributeMaxDynamicSharedMemorySize, LDS_BYTES) != hipSuccess) { fprintf(stderr, "kernel_launch: hipFuncSetAttribute failed\n"); grid = -1; return; }
        int dev = 0, cus = 0; (void)hipGetDevice(&dev); (void)hipDeviceGetAttribute(&cus, hipDeviceAttributeMultiprocessorCount, dev);
        int per_cu = 0; (void)hipOccupancyMaxActiveBlocksPerMultiprocessor(&per_cu, (const void*)mk_fwd, 512, LDS_BYTES); (void)hipGetLastError();
        if (cus != 256 || per_cu < 1) fprintf(stderr, "kernel_launch: note: cus %d per_cu %d\n", cus, per_cu);
        grid = 256;
    }
    if (grid < 0) return;
    (void)hipMemsetAsync((char*)d_ws + WS_CTL, 0, CTL_ZERO_BYTES, stream);
    Params a{};
    for (int i = 0; i < 24; ++i) a.in[i] = (const float*)d_in[i];
    a.out = (float*)d_out; a.ws = (unsigned char*)d_ws;
#if MK_ONE_LAUNCH
    a.ph_lo = 0; a.ph_hi = N_PHASES;
    hipLaunchKernelGGL(mk_fwd, dim3(grid), dim3(512), LDS_BYTES, stream, a);
#else
    for (int ph = 0; ph < N_PHASES; ++ph) { a.ph_lo = ph; a.ph_hi = ph + 1; hipLaunchKernelGGL(mk_fwd, dim3(grid), dim3(512), LDS_BYTES, stream, a); }
#endif
}
```

```cpp
#include <hip/hip_runtime.h>
#include <cstdio>
#include <cstdint>

#ifndef MK_ONE_LAUNCH
#define MK_ONE_LAUNCH 1
#endif

#define GAS __attribute__((address_space(1)))
#define LAS __attribute__((address_space(3)))
typedef unsigned short bf16;
typedef unsigned v4u __attribute__((ext_vector_type(4)));
typedef unsigned v2u __attribute__((ext_vector_type(2)));
typedef float f32x4 __attribute__((ext_vector_type(4)));
typedef float f32x2 __attribute__((ext_vector_type(2)));
typedef short bf16x8 __attribute__((ext_vector_type(8)));
typedef GAS unsigned gu32;
typedef int v8i __attribute__((ext_vector_type(8)));
typedef int v4i __attribute__((ext_vector_type(4)));

constexpr int DM = 2048, MTOK = 8192, SEQ = 4096, MEMR = 512, NPROJ = 7680, INW = 7184;
constexpr int NEXP = 32;
constexpr float EPS = 1e-6f;
constexpr int C_GQ = 0, C_GK = 512, C_GV = 1024, C_GG = 2048, C_GA = 3072, C_HQ = 3584, C_HK = 4608, C_HV = 5632, C_HG = 6656;

constexpr int PBLD = 256;
__device__ __forceinline__ size_t pb_off(int t, int col) { return ((size_t)((t >> 8) * 30 + (col >> 8)) << 16) + (size_t)((t & 255) << 8) + (col & 255); }
constexpr size_t MiB = 1ull << 20;
constexpr size_t WS_CTL = 0, CTL_ZERO_BYTES = 128 * 1024;
constexpr size_t WS_WTIN = 1 * MiB;
constexpr size_t WS_WTOUT = 31 * MiB;
constexpr size_t WS_WQN = 39 * MiB;
constexpr size_t WS_WOT = 47 * MiB;
constexpr size_t WS_WTKV = 55 * MiB;
constexpr size_t WS_WRT = 71 * MiB;
constexpr size_t WS_EXP1 = 72 * MiB;
constexpr size_t WS_EXP2 = 328 * MiB;
constexpr size_t WS_A1B = 456 * MiB;
constexpr size_t WS_MEMN = 488 * MiB;
constexpr size_t WS_KV = 490 * MiB;
constexpr size_t WS_PB = 494 * MiB;
constexpr size_t WS_Y = WS_PB + 48 * MiB;
constexpr size_t WS_LA = 614 * MiB;
constexpr size_t WS_LF = 630 * MiB;
constexpr size_t WS_UT = 662 * MiB;
constexpr size_t WS_DB = 726 * MiB;
constexpr size_t WS_ON = 727 * MiB;
constexpr size_t WS_H1F = 759 * MiB;
constexpr size_t WS_H1B = 823 * MiB;
constexpr size_t WS_MT = 855 * MiB;
constexpr size_t WS_NT = 863 * MiB;
constexpr size_t WS_PBUF = 871 * MiB;
constexpr size_t WS_LIST = 887 * MiB;
constexpr size_t WS_GATEW = 888 * MiB;
constexpr size_t WS_HID = 889 * MiB;
constexpr size_t WS_END = 913 * MiB;
constexpr int CW_XQ = 26624;
constexpr int CW_TMO = 0, CW_BAR = 4096, CW_CNT = 8192, CW_SS1 = 16384, CW_MT = 24576;
static_assert((CW_MT + 16 * 96) * 4 <= (int)CTL_ZERO_BYTES, "ctl");

constexpr int LDS_BYTES = 163840;
constexpr int RING_BYTES = 131072;
constexpr int EPI_OFF = RING_BYTES;
constexpr int TBL_OFF = RING_BYTES + 8192;
constexpr int MISC_OFF = LDS_BYTES - 256;

#define LDS_WAIT() asm volatile("s_waitcnt lgkmcnt(0)" ::: "memory")
#define VM_WAIT() asm volatile("s_waitcnt vmcnt(0)" ::: "memory")
#define RLX_AGENT __ATOMIC_RELAXED, __HIP_MEMORY_SCOPE_AGENT
__device__ __forceinline__ float bf2f(unsigned v) { return __uint_as_float(v << 16); }
__device__ __forceinline__ unsigned f2bf(float f) { unsigned u = __float_as_uint(f); return (u + 0x7fffu + ((u >> 16) & 1u)) >> 16; }
__device__ __forceinline__ unsigned pk2(float lo, float hi) { return f2bf(lo) | (f2bf(hi) << 16); }
__device__ __forceinline__ float wave_sum(float v) {
#pragma unroll
    for (int o = 1; o < 64; o <<= 1) v += __shfl_xor(v, o);
    return v;
}
__device__ __forceinline__ float sigmoidf_(float x) { return 1.f / (1.f + __expf(-x)); }
__device__ __forceinline__ float siluf_(float x) { return x / (1.f + __expf(-x)); }
__device__ __forceinline__ float logsigmoidf_(float x) { return fminf(x, 0.f) - __logf(1.f + __expf(-fabsf(x))); }

#define XB_TMO      128
#define XB_XCNT(j)  (256  + 64 * (j))
#define XB_XSUB(j)  (1280 + 64 * (j))
#define XB_XGEN(j)  (2304 + 64 * (j))
#define XB_TOP      3328
#define XB_TOPGEN   3392
#define XCD_BAR_WORDS 3456
#define XB_SPIN_CAP (1u << 18)
__device__ __forceinline__ unsigned xb_ld(unsigned* p)              { return __hip_atomic_load(p, __ATOMIC_RELAXED, __HIP_MEMORY_SCOPE_AGENT); }
__device__ __forceinline__ unsigned xb_add(unsigned* p, unsigned v) { return __hip_atomic_fetch_add(p, v, __ATOMIC_RELAXED, __HIP_MEMORY_SCOPE_AGENT); }
__device__ __forceinline__ unsigned xb_xcc_id() { return (unsigned)__builtin_amdgcn_s_getreg((3 << 11) | 20) & 0xFu; }
#define XB_SPIN(cond, bar) do { unsigned _sp = 0; while (cond) { __builtin_amdgcn_s_sleep(1); \
    if ((++_sp & 255u) == 0u) { if (xb_ld(&(bar)[XB_TMO])) break; if (_sp > XB_SPIN_CAP) { atomicAdd(&(bar)[XB_TMO], 1u); break; } } } } while (0)
struct XcdBarrier { unsigned* bar; unsigned x; volatile LAS unsigned* st; };
__device__ __forceinline__ XcdBarrier xcd_barrier_post(unsigned* bar, volatile LAS unsigned* st) {
    XcdBarrier b; b.bar = bar; b.x = xb_xcc_id(); b.st = st;
    if (threadIdx.x == 0) (void)xb_add(&bar[XB_XCNT(b.x)], 1u);
    return b;
}
__device__ __forceinline__ void xcd_barrier_complete(unsigned* bar, unsigned x, unsigned& nloc, unsigned& nx) {
    const unsigned G = gridDim.x * gridDim.y * gridDim.z;
    unsigned sum, cnt, mine, sp = 0u;
    for (;;) {
        sum = 0u; cnt = 0u; mine = 0u;
#pragma unroll
        for (unsigned j = 0; j < 16; ++j) { const unsigned c = xb_ld(&bar[XB_XCNT(j)]); sum += c; cnt += (c > 0u) ? 1u : 0u; mine = (j == x) ? c : mine; }
        if (sum == G) break;
        __builtin_amdgcn_s_sleep(1);
        if ((++sp & 255u) == 0u) { if (xb_ld(&bar[XB_TMO])) break; if (sp > XB_SPIN_CAP) { atomicAdd(&bar[XB_TMO], 1u); break; } }
    }
    nloc = mine > 0u ? mine : 1u; nx = cnt > 0u ? cnt : 1u;
}
__device__ __forceinline__ void xcd_barrier(const XcdBarrier& b) {
    asm volatile("s_waitcnt vmcnt(0)" ::: "memory");
    __syncthreads();
    if (threadIdx.x == 0) {
        unsigned* bar = b.bar;
        __builtin_amdgcn_s_waitcnt(0);
        unsigned nloc = b.st[0], nx = b.st[1];
        if (nloc == 0u) { xcd_barrier_complete(bar, b.x, nloc, nx); b.st[0] = nloc; b.st[1] = nx; }
        const unsigned old = xb_add(&bar[XB_XSUB(b.x)], 1u);
        const unsigned gen = old / nloc;
        if (old + 1u == (gen + 1u) * nloc) {
            __builtin_amdgcn_fence(__ATOMIC_RELEASE, "agent");
            asm volatile("s_waitcnt vmcnt(0)" ::: "memory");
            const unsigned og = xb_add(&bar[XB_TOP], 1u);
            const unsigned tg = og / nx;
            if (og + 1u == (tg + 1u) * nx) xb_add(&bar[XB_TOPGEN], 1u);
            else XB_SPIN(xb_ld(&bar[XB_TOPGEN]) == tg, bar);
            __builtin_amdgcn_fence(__ATOMIC_ACQUIRE, "agent");
            xb_add(&bar[XB_XGEN(b.x)], 1u);
            asm volatile("s_waitcnt vmcnt(0)" ::: "memory");
        } else {
            XB_SPIN(xb_ld(&bar[XB_XGEN(b.x)]) == gen, bar);
            __builtin_amdgcn_fence(__ATOMIC_ACQUIRE, "agent");
            asm volatile("s_waitcnt vmcnt(0)" ::: "memory");
        }
    }
    __syncthreads();
}

struct Params { const float* in[24]; float* out; unsigned char* ws; int ph_lo, ph_hi; };
enum { I_X = 0, I_MEM, I_NMIXG, I_WIN, I_WAUP, I_BALPHA, I_GLAG, I_LBLOG, I_HGRNG, I_WMIXOUT, I_NXG, I_NMEMG, I_WQ, I_WKV, I_WO, I_NFFNG, I_WRG, I_BRG, I_WRE, I_BRE,
       I_WEG, I_WEU, I_WED, I_NFING };

struct Ctx {
    Params p; LAS unsigned char* lds; int tid, lane, wave, vcu, G;
};
#define WSP(T, off) ((T*)(C.p.ws + (off)))

__device__ __forceinline__ int rowmap(int kind, int n) {
    if (kind == 0) return n;
    if (kind == 1) return n < 3072 ? n : (n < 3088 ? -1 : (n < INW ? n + 496 : -1));
    if (kind == 2) return ((n >> 7) << 8) + (n & 127);
    return ((n >> 7) << 8) + 128 + (n & 127);
}
__device__ __forceinline__ void transpose_load(const float* W, int ldsrc, int nvalid, int k0, int n0, int lane, float (&tv)[32]) {
    const int nn = n0 + (lane & 31); const bool ok = nn < nvalid;
    const float* wp = W + (size_t)(k0 + (lane >> 5)) * ldsrc + (ok ? nn : 0);
#pragma unroll
    for (int i = 0; i < 32; ++i) tv[i] = __builtin_nontemporal_load(wp + (size_t)(2 * i) * ldsrc);
    if (!ok) {
#pragma unroll
        for (int i = 0; i < 32; ++i) tv[i] = 0.f; }
}
__device__ __forceinline__ void transpose_finish(const float (&tv)[32], int nvalid, int k0, int n0, bf16* WT, int lddst, int kind, LAS float* scr, int lane) {
#pragma unroll
    for (int i = 0; i < 32; ++i) { const int kk = 2 * i + (lane >> 5); scr[kk * 33 + (lane & 31)] = tv[i]; }
    LDS_WAIT(); asm volatile("" ::: "memory");
    const int c = lane & 7;
#pragma unroll
    for (int j = 0; j < 4; ++j) { const int n = (lane >> 3) + 8 * j; const LAS float* s = scr + (8 * c) * 33 + n;
        v4u o; o.x = pk2(s[0 * 33], s[1 * 33]); o.y = pk2(s[2 * 33], s[3 * 33]); o.z = pk2(s[4 * 33], s[5 * 33]); o.w = pk2(s[6 * 33], s[7 * 33]);
        const int r = (n0 + n < nvalid) ? rowmap(kind, n0 + n) : -1;
        if (r >= 0) *(v4u*)(WT + (size_t)r * lddst + k0 + 8 * c) = o; }
    LDS_WAIT(); asm volatile("" ::: "memory");
}
__device__ __forceinline__ void transpose_item(const float* W, int ldsrc, int nvalid, int k0, int n0, bf16* WT, int lddst, int kind, LAS float* scr, int lane) {
    float tv[32]; transpose_load(W, ldsrc, nvalid, k0, n0, lane, tv); transpose_finish(tv, nvalid, k0, n0, WT, lddst, kind, scr, lane);
}
__device__ __forceinline__ void rms_row_to_bf16(const float* xrow, const float* g, bf16* orow, int lane) {
    const f32x4* xr = (const f32x4*)xrow + lane; const f32x4* gr = (const f32x4*)g + lane;
    f32x4 v[8]; float s = 0.f;
#pragma unroll
    for (int j = 0; j < 8; ++j) { v[j] = __builtin_nontemporal_load(xr + 64 * j); s += (v[j].x * v[j].x + v[j].y * v[j].y) + (v[j].z * v[j].z + v[j].w * v[j].w); }
    const float rstd = rsqrtf(wave_sum(s) * (1.f / DM) + EPS);
    v2u* o8 = (v2u*)orow + lane; f32x4 g8[8];
#pragma unroll
    for (int j = 0; j < 8; ++j) g8[j] = gr[64 * j];
#pragma unroll
    for (int j = 0; j < 8; ++j) { const f32x4 gg = g8[j]; v2u w; w.x = pk2(v[j].x * rstd * gg.x, v[j].y * rstd * gg.y); w.y = pk2(v[j].z * rstd * gg.z, v[j].w * rstd * gg.w); o8[64 * j] = w; }
}
constexpr float WSCALE = 64.f, WSCALE_INV = 1.f / 64.f;
__device__ __forceinline__ unsigned pk4_fp8(float a, float b, float c, float d) {
    a = __builtin_amdgcn_fmed3f(a, -448.f, 448.f); b = __builtin_amdgcn_fmed3f(b, -448.f, 448.f); c = __builtin_amdgcn_fmed3f(c, -448.f, 448.f); d = __builtin_amdgcn_fmed3f(d, -448.f, 448.f);
    int r = __builtin_amdgcn_cvt_pk_fp8_f32(a, b, 0, false); r = __builtin_amdgcn_cvt_pk_fp8_f32(c, d, r, true); return (unsigned)r; }
struct XItem { const float* W; unsigned char* WT; int ld, k0, n0, ldd, kind; };
__device__ __forceinline__ XItem expert_item(const Ctx& C, int it) {
    XItem x; const int e = it / 1536, q = it % 1536, which = q >> 9, j = q & 511;
    if (which == 0) { x.W = C.p.in[I_WEG] + (size_t)e * 2048 * 1024; x.ld = 1024; x.k0 = 128 * (j / 32); x.n0 = 32 * (j % 32); x.WT = WSP(unsigned char, WS_EXP1) + (size_t)e * 2048 * 2048; x.ldd = 2048; x.kind = 2; }
    else if (which == 1) { x.W = C.p.in[I_WEU] + (size_t)e * 2048 * 1024; x.ld = 1024; x.k0 = 128 * (j / 32); x.n0 = 32 * (j % 32); x.WT = WSP(unsigned char, WS_EXP1) + (size_t)e * 2048 * 2048; x.ldd = 2048; x.kind = 3; }
    else { x.W = C.p.in[I_WED] + (size_t)e * 1024 * 2048; x.ld = 2048; x.k0 = 128 * (j / 64); x.n0 = 32 * (j % 64); x.WT = WSP(unsigned char, WS_EXP2) + (size_t)e * 2048 * 1024; x.ldd = 1024; x.kind = 0; }
    return x;
}
__device__ __forceinline__ void x_load(const XItem& x, int lane, float (&tv)[64]) {
    const float* wp = x.W + (size_t)(x.k0 + (lane >> 5)) * x.ld + x.n0 + (lane & 31);
#pragma unroll
    for (int i = 0; i < 64; ++i) tv[i] = __builtin_nontemporal_load(wp + (size_t)(2 * i) * x.ld);
}
__device__ __forceinline__ void x_finish(const float (&tv)[64], const XItem& x, LAS float* scr, int lane) {
#pragma unroll
    for (int i = 0; i < 64; ++i) { const int kk = 2 * i + (lane >> 5); scr[kk * 33 + (lane & 31)] = tv[i]; }
    LDS_WAIT(); asm volatile("" ::: "memory");
    const int c = lane & 7;
#pragma unroll
    for (int j = 0; j < 4; ++j) { const int n = (lane >> 3) + 8 * j; const LAS float* s = scr + (16 * c) * 33 + n;
        v4u o; o.x = pk4_fp8(s[0 * 33] * WSCALE, s[1 * 33] * WSCALE, s[2 * 33] * WSCALE, s[3 * 33] * WSCALE); o.y = pk4_fp8(s[4 * 33] * WSCALE, s[5 * 33] * WSCALE, s[6 * 33] * WSCALE, s[7 * 33] * WSCALE);
        o.z = pk4_fp8(s[8 * 33] * WSCALE, s[9 * 33] * WSCALE, s[10 * 33] * WSCALE, s[11 * 33] * WSCALE); o.w = pk4_fp8(s[12 * 33] * WSCALE, s[13 * 33] * WSCALE, s[14 * 33] * WSCALE, s[15 * 33] * WSCALE);
        __builtin_nontemporal_store(o, (v4u*)(x.WT + (size_t)rowmap(x.kind, x.n0 + n) * x.ldd + x.k0 + 16 * c)); }
    LDS_WAIT(); asm volatile("" ::: "memory");
}
constexpr int NX_TOTAL = 32 * 1536;
constexpr int NX_DEFER = 0;
__device__ __forceinline__ void convert_expert_items(const Ctx& C, int ibeg, int iend, int widx, int nw) {
    LAS float* scr = (LAS float*)(C.lds + C.wave * 16896);
    for (int it = ibeg + widx; it < iend; it += nw) { const XItem x = expert_item(C, it); float tv[64]; x_load(x, C.lane, tv); x_finish(tv, x, scr, C.lane); }
}
constexpr int NPREP = 2048 + 2048 + 1024;
constexpr unsigned NXQ = NPREP + NX_TOTAL - NX_DEFER;
__device__ __forceinline__ void prep_item(const Ctx& C, int it, LAS float* scr) {
    if (it < 2048) { const int kb = it >> 6, nb = it & 63; transpose_item(C.p.in[I_WMIXOUT], DM, DM, 64 * kb, 32 * nb, WSP(bf16, WS_WTOUT), DM, 0, scr, C.lane); return; }
    if (it < 4096) { const int r = it - 2048, kb = r >> 6, nb = r & 63; transpose_item(C.p.in[I_WO], DM, DM, 64 * kb, 32 * nb, WSP(bf16, WS_WOT), DM, 0, scr, C.lane); return; }
    { const int r = it - 4096; const float* wq = C.p.in[I_WQ]; const float* g = C.p.in[I_NXG]; bf16* o = WSP(bf16, WS_WQN); f32x4 a[2][4][2];
#pragma unroll
      for (int j = 0; j < 2; ++j)
#pragma unroll
          for (int c = 0; c < 4; ++c) { const float* p = wq + (size_t)(2 * r + j) * DM + c * 512 + C.lane * 8; a[j][c][0] = __builtin_nontemporal_load((const f32x4*)p); a[j][c][1] = __builtin_nontemporal_load((const f32x4*)(p + 4)); }
#pragma unroll
      for (int j = 0; j < 2; ++j) { const float gk = g[2 * r + j];
#pragma unroll
          for (int c = 0; c < 4; ++c) { v4u w; w.x = pk2(a[j][c][0].x * gk, a[j][c][0].y * gk); w.y = pk2(a[j][c][0].z * gk, a[j][c][0].w * gk); w.z = pk2(a[j][c][1].x * gk, a[j][c][1].y * gk); w.w = pk2(a[j][c][1].z * gk, a[j][c][1].w * gk);
              *(v4u*)(o + (size_t)(2 * r + j) * DM + c * 512 + C.lane * 8) = w; } } }
}
__device__ __forceinline__ void queue_item(const Ctx& C, unsigned q) {
    const int qi = (int)q + C.wave;
    if (qi < NPREP) { prep_item(C, qi, (LAS float*)(C.lds + C.wave * 16896)); return; }
    const int it = NX_DEFER + qi - NPREP;
    if (it < NX_TOTAL) { const XItem x = expert_item(C, it); float tv[64]; x_load(x, C.lane, tv); x_finish(tv, x, (LAS float*)(C.lds + C.wave * 16896), C.lane); }
}
template <bool BARRIER>
__device__ __forceinline__ void xq_loop(const Ctx& C, unsigned* bar, unsigned x) {
    volatile LAS unsigned* st = (volatile LAS unsigned*)(C.lds + MISC_OFF);
    unsigned* queue = WSP(unsigned, WS_CTL) + CW_XQ;
    if (threadIdx.x == 0 && !(BARRIER && st[8]) && !st[11] && !st[12]) { const unsigned q = xb_add(queue, 8u); st[10] = q; if (q < NXQ) st[11] = 1u; else st[12] = 1u; }
    __syncthreads();
    unsigned done = BARRIER ? st[8] : 0u, have = st[11], q = st[10];
    __syncthreads();
    while (!done) {
        if (!have) {
            if (!BARRIER) break;
            if (threadIdx.x == 0) { const unsigned gen = st[9]; XB_SPIN(xb_ld(&bar[XB_XGEN(x)]) == gen, bar); __builtin_amdgcn_fence(__ATOMIC_ACQUIRE, "agent"); asm volatile("s_waitcnt vmcnt(0)" ::: "memory"); }
            __syncthreads();
            break;
        }
        unsigned pg = 0u, nq = NXQ;
        if (threadIdx.x == 0) { if (BARRIER) pg = xb_ld(&bar[XB_XGEN(x)]); if (!st[12]) nq = xb_add(queue, 8u); }
        queue_item(C, q);
        if (threadIdx.x == 0) {
            st[10] = nq; if (nq < NXQ) st[11] = 1u; else { st[11] = 0u; st[12] = 1u; }
            if (BARRIER && pg != st[9]) { __builtin_amdgcn_fence(__ATOMIC_ACQUIRE, "agent"); asm volatile("s_waitcnt vmcnt(0)" ::: "memory"); st[8] = 1u; }
        }
        __syncthreads();
        done = BARRIER ? st[8] : 0u; have = st[11]; q = st[10];
        __syncthreads();
    }
}
__device__ __forceinline__ void xcd_barrier_work(const XcdBarrier& b, const Ctx& C) {
    asm volatile("s_waitcnt vmcnt(0)" ::: "memory");
    __syncthreads();
    volatile LAS unsigned* st = b.st; unsigned* bar = b.bar;
    if (threadIdx.x == 0) {
        __builtin_amdgcn_s_waitcnt(0);
        unsigned nloc = st[0], nx = st[1];
        if (nloc == 0u) { xcd_barrier_complete(bar, b.x, nloc, nx); st[0] = nloc; st[1] = nx; }
        const unsigned old = xb_add(&bar[XB_XSUB(b.x)], 1u);
        const unsigned gen = old / nloc;
        if (old + 1u == (gen + 1u) * nloc) {
            __builtin_amdgcn_fence(__ATOMIC_RELEASE, "agent");
            asm volatile("s_waitcnt vmcnt(0)" ::: "memory");
            const unsigned og = xb_add(&bar[XB_TOP], 1u);
            const unsigned tg = og / nx;
            if (og + 1u == (tg + 1u) * nx) xb_add(&bar[XB_TOPGEN], 1u);
            else XB_SPIN(xb_ld(&bar[XB_TOPGEN]) == tg, bar);
            __builtin_amdgcn_fence(__ATOMIC_ACQUIRE, "agent");
            xb_add(&bar[XB_XGEN(b.x)], 1u);
            asm volatile("s_waitcnt vmcnt(0)" ::: "memory");
            st[8] = 1u;
        } else if (old - gen * nloc >= (3u * nloc) / 4u) {
            XB_SPIN(xb_ld(&bar[XB_XGEN(b.x)]) == gen, bar);
            __builtin_amdgcn_fence(__ATOMIC_ACQUIRE, "agent");
            asm volatile("s_waitcnt vmcnt(0)" ::: "memory");
            st[8] = 1u;
        } else { st[9] = gen; st[8] = 0u; }
    }
    xq_loop<true>(C, bar, b.x);
}
__device__ __forceinline__ void queue_drain(const Ctx& C) { xq_loop<false>(C, nullptr, 0u); }
__device__ __forceinline__ void queue_deadline(const Ctx& C) {
    volatile LAS unsigned* st = (volatile LAS unsigned*)(C.lds + MISC_OFF); unsigned* queue = WSP(unsigned, WS_CTL) + CW_XQ;
    __syncthreads();
    const unsigned pend = st[11], pq = st[10];
    __syncthreads();
    if (pend && pq < (unsigned)NPREP) { queue_item(C, pq); if (threadIdx.x == 0) st[11] = 0u; }
    for (;;) {
        if (threadIdx.x == 0) { unsigned t = NXQ; if (st[10] < (unsigned)NPREP && xb_ld(queue) < (unsigned)NPREP) t = xb_add(queue, 8u); st[13] = t; }
        __syncthreads();
        const unsigned t = st[13];
        __syncthreads();
        if (t >= NXQ) break;
        queue_item(C, t);
        if (t >= (unsigned)NPREP) break;
    }
}
__device__ __forceinline__ void p0_prologue(const Ctx& C) {
    LAS float* scr = (LAS float*)(C.lds + C.wave * 16896);
    const int gw = C.vcu * 8 + C.wave, NGW = C.G * 8;
    const int gt = gw * 64 + C.lane, NGT = NGW * 64;
    constexpr int I0 = 32 * 225, I3 = 32 * 128;
    constexpr int NITEMS = I0 + I3;
    for (int it = gw; it < NITEMS; it += NGW) {
        int r = it;
        if (r < I0) { const int kb = r / 225, nb = r % 225; transpose_item(C.p.in[I_WIN], INW, INW, 64 * kb, 32 * nb, WSP(bf16, WS_WTIN), DM, 1, scr, C.lane); continue; } r -= I0;
        { const int kb = r / 128, nb = r % 128; transpose_item(C.p.in[I_WKV], 4096, 4096, 64 * kb, 32 * nb, WSP(bf16, WS_WTKV), DM, 0, scr, C.lane); }
    }
    { const float* win = C.p.in[I_WIN]; const float* wup = C.p.in[I_WAUP]; bf16* o = WSP(bf16, WS_WTIN);
      for (int it = NGW - 1 - gw; it < 256 * 8; it += NGW) { const int k8 = __builtin_amdgcn_readfirstlane(it >> 3), c = (it & 7) * 64 + C.lane; float up[16];
#pragma unroll
          for (int j = 0; j < 16; ++j) up[j] = wup[j * 512 + c];
          float r[8];
#pragma unroll
          for (int kk = 0; kk < 8; ++kk) { const float* wr = win + (size_t)(k8 * 8 + kk) * INW + 3072; float s = 0.f;
#pragma unroll
              for (int j = 0; j < 16; ++j) s += wr[j] * up[j];
              r[kk] = s; }
          v4u w; w.x = pk2(r[0], r[1]); w.y = pk2(r[2], r[3]); w.z = pk2(r[4], r[5]); w.w = pk2(r[6], r[7]);
          *(v4u*)(o + (size_t)(C_GA + c) * DM + k8 * 8) = w; } }
    { const float* wre = C.p.in[I_WRE]; const float* wrg = C.p.in[I_WRG]; const float* g = C.p.in[I_NFFNG]; float* o = WSP(float, WS_WRT);
      for (int id = gt; id < 48 * DM; id += NGT) { const int c = id >> 11, k = id & 2047; float v = 0.f;
          if (c < 32) v = g[k] * wre[k * 32 + c]; else if (c < 36) v = g[k] * wrg[k * 4 + (c - 32)];
          o[id] = v; } }
    { const int m0 = NGW - 1 - gw; const f32x4* gr = (const f32x4*)C.p.in[I_NMIXG] + C.lane; f32x4 g8[8];
#pragma unroll
      for (int j = 0; j < 8; ++j) g8[j] = gr[64 * j];
      for (int mb = m0; mb < MTOK; mb += 4 * NGW) {
          f32x4 v[4][8];
#pragma unroll
          for (int r = 0; r < 4; ++r) { const int m = mb + r * NGW; const f32x4* xr = (const f32x4*)(C.p.in[I_X] + (size_t)(m < MTOK ? m : mb) * DM) + C.lane;
#pragma unroll
              for (int j = 0; j < 8; ++j) v[r][j] = __builtin_nontemporal_load(xr + 64 * j); }
#pragma unroll
          for (int r = 0; r < 4; ++r) { const int m = mb + r * NGW; if (m < MTOK) { float sq = 0.f;
#pragma unroll
              for (int j = 0; j < 8; ++j) sq += (v[r][j].x * v[r][j].x + v[r][j].y * v[r][j].y) + (v[r][j].z * v[r][j].z + v[r][j].w * v[r][j].w);
              const float rstd = rsqrtf(wave_sum(sq) * (1.f / DM) + EPS); v2u* o8 = (v2u*)(WSP(bf16, WS_A1B) + (size_t)m * DM) + C.lane;
#pragma unroll
              for (int j = 0; j < 8; ++j) { const f32x4 gg = g8[j]; v2u w; w.x = pk2(v[r][j].x * rstd * gg.x, v[r][j].y * rstd * gg.y); w.y = pk2(v[r][j].z * rstd * gg.z, v[r][j].w * rstd * gg.w); o8[64 * j] = w; } } } }
      for (int m = m0; m < MEMR; m += NGW) rms_row_to_bf16(C.p.in[I_MEM] + (size_t)m * DM, C.p.in[I_NMEMG], WSP(bf16, WS_MEMN) + (size_t)m * DM, C.lane); }
}

struct Unit { const char* A; const char* B; bf16* Cb; unsigned lda2, ldb2; int ldc; int pm, pn, mode, e, mtl, cnt, mtg; };
enum { GK_PROJ = 1, GK_XPRE = 2, GK_OUT = 3, GK_SCORE = 4, GK_PV = 5, GK_MOE1 = 7, GK_MOE2 = 8 };

__device__ __forceinline__ void static_tile(int L, int nM, int nN, int& pm, int& pn) {
    const int nwg = nM * nN; int wgid = L;
    { const int q = nwg / 8, r = nwg % 8, xcd = wgid % 8, off = wgid / 8; wgid = (xcd < r ? xcd * (q + 1) : r * (q + 1) + (xcd - r) * q) + off; }
    const int nig = 2 * nN, gid = wgid / nig, fm = gid * 2, gsz = (nM - fm) < 2 ? (nM - fm) : 2;
    pm = fm + ((wgid % nig) % gsz); pn = (wgid % nig) / gsz;
}
__device__ __forceinline__ int gemm_K(int kind) { return kind == GK_XPRE ? 512 : ((kind == GK_PV || kind == GK_MOE2) ? 1024 : 2048); }

__device__ __forceinline__ bool unit_next(const Ctx& C, int kind, int i, Unit& u) {
    const int bx = blockIdx.x, G = C.G;
    u.e = 0; u.mtl = 0; u.cnt = 0; u.mtg = 0; u.mode = 0; u.Cb = nullptr; u.ldc = 0;
    if (kind == GK_PROJ) {
        const int L = i * G + bx; if (L >= 992) return false;
        u.lda2 = 4096; u.ldb2 = 4096;
        if (L < 960) { static_tile(L, 32, 30, u.pm, u.pn);
            u.A = (const char*)WSP(bf16, WS_A1B) + (size_t)u.pm * 256 * 4096; u.B = (const char*)WSP(bf16, WS_WTIN) + (size_t)u.pn * 256 * 4096;
            u.mode = 0;
            u.Cb = WSP(bf16, WS_PB) + ((size_t)(u.pm * 30 + u.pn) << 16); u.ldc = PBLD; }
        else { const int j = L - 960; u.pm = j >> 4; u.pn = j & 15;
            u.A = (const char*)WSP(bf16, WS_MEMN) + (size_t)u.pm * 256 * 4096; u.B = (const char*)WSP(bf16, WS_WTKV) + (size_t)u.pn * 256 * 4096;
            u.mode = 0; u.Cb = WSP(bf16, WS_KV) + (size_t)u.pm * 256 * 4096 + u.pn * 256; u.ldc = 4096; }
        return true;
    }
    if (kind == GK_XPRE) {
        const int L = i * G + bx; if (L >= 128) return false;
        const int q = L & 63, b = q >> 5, h = (q >> 3) & 3, t = q & 7; u.pm = 0; u.pn = t;
        if (L < 64) {
            u.A = (const char*)WSP(bf16, WS_KV) + (size_t)(b * 256) * 8192 + h * 1024; u.lda2 = 8192;
            u.B = (const char*)WSP(bf16, WS_WQN) + (size_t)(t * 256) * 4096 + h * 1024; u.ldb2 = 4096;
            u.Cb = (bf16*)(WSP(unsigned char, WS_MT) + (size_t)(b * 1024 + h * 256) * 2048 + t * 256); u.ldc = 2048;
        } else {
            u.A = (const char*)WSP(bf16, WS_WOT) + (size_t)(t * 256) * 4096 + h * 1024; u.lda2 = 4096;
            u.B = (const char*)WSP(bf16, WS_KV) + (size_t)(b * 256) * 8192 + 4096 + h * 1024; u.ldb2 = 8192;
            u.Cb = (bf16*)(WSP(unsigned char, WS_NT) + (size_t)(b * 2048 + t * 256) * 1024 + h * 256); u.ldc = 1024;
        }
        return true;
    }
    if (kind == GK_OUT) {
        const int L = i * G + bx; if (L >= 256) return false;
        static_tile(L, 32, 8, u.pm, u.pn); u.lda2 = 4096; u.ldb2 = 4096;
        u.A = (const char*)WSP(bf16, WS_ON) + (size_t)u.pm * 256 * 4096; u.B = (const char*)WSP(bf16, WS_WTOUT) + (size_t)u.pn * 256 * 4096;
        return true;
    }
    if (kind == GK_SCORE) {
        const int L = i * G + bx; if (L >= 128) return false;
        static_tile(L, 32, 4, u.pm, u.pn); u.lda2 = 2048; u.ldb2 = 2048;
        u.A = (const char*)WSP(unsigned char, WS_H1F) + (size_t)u.pm * 256 * 2048; u.B = (const char*)WSP(unsigned char, WS_MT) + (size_t)((u.pm >> 4) * 1024 + u.pn * 256) * 2048;
        return true;
    }
    if (kind == GK_PV) {
        const int L = i * G + bx; if (L >= 256) return false;
        static_tile(L, 32, 8, u.pm, u.pn); u.lda2 = 1024; u.ldb2 = 1024;
        u.A = (const char*)WSP(unsigned char, WS_PBUF) + (size_t)u.pm * 256 * 1024; u.B = (const char*)WSP(unsigned char, WS_NT) + (size_t)((u.pm >> 4) * 2048 + u.pn * 256) * 1024;
        return true;
    }
    {
        const LAS int* ts = (const LAS int*)(C.lds + TBL_OFF); const LAS int* cn = ts + 40;
        const int L = i * G + (kind == GK_MOE2 ? G - 1 - C.vcu : C.vcu); const int TT8 = ts[32] * 8; if (L >= TT8) return false;
        int e = 0;
#pragma unroll
        for (int sp = 16; sp >= 1; sp >>= 1) if (L >= ts[e + sp] * 8) e += sp;
        const int rem = L - ts[e] * 8, nte = ts[e + 1] - ts[e];
        u.e = __builtin_amdgcn_readfirstlane(e); u.pn = __builtin_amdgcn_readfirstlane(rem / nte); u.mtl = __builtin_amdgcn_readfirstlane(rem % nte);
        u.mtg = __builtin_amdgcn_readfirstlane(ts[e]) + u.mtl; u.cnt = __builtin_amdgcn_readfirstlane(cn[e]); u.pm = u.mtg;
        if (kind == GK_MOE1) { u.lda2 = 2048; u.ldb2 = 2048; u.A = (const char*)WSP(unsigned char, WS_A1B);
            u.B = (const char*)WSP(unsigned char, WS_EXP1) + (size_t)u.e * 2048 * 2048 + (size_t)u.pn * 256 * 2048; }
        else { u.lda2 = 1024; u.ldb2 = 1024; u.A = (const char*)WSP(unsigned char, WS_HID) + (size_t)u.mtg * 256 * 1024;
            if (C.wave == 0) { unsigned* ctr = WSP(unsigned, WS_CTL) + CW_MT + 16 * u.mtg; unsigned sp = 0;
                while ((unsigned)__builtin_amdgcn_readfirstlane((int)__hip_atomic_load(ctr, RLX_AGENT)) < 8u) { __builtin_amdgcn_s_sleep(2); if (++sp > (1u << 22)) { if (C.lane == 0) atomicAdd(WSP(unsigned, WS_CTL) + CW_TMO, 1u); break; } }
                __builtin_amdgcn_fence(__ATOMIC_ACQUIRE, "agent"); asm volatile("s_waitcnt vmcnt(0)" ::: "memory"); }
            asm volatile("" ::: "memory"); __builtin_amdgcn_s_barrier(); asm volatile("" ::: "memory");
            u.B = (const char*)WSP(unsigned char, WS_EXP2) + (size_t)u.e * 2048 * 1024 + (size_t)u.pn * 256 * 1024; }
        return true;
    }
}
__device__ __forceinline__ unsigned a_row_off(const Ctx& C, int kind, const Unit& u, int r) {
    if (kind == GK_MOE1) { const int slot = u.mtl * 256 + r; const int tok = WSP(int, WS_LIST)[u.e * 8192 + (slot < u.cnt ? slot : u.cnt - 1)] >> 1; return (unsigned)tok * 2048u; }
    return (unsigned)r * u.lda2;
}

__device__ __forceinline__ unsigned cvt_pk_bf16(float lo, float hi) { unsigned r; asm volatile("v_cvt_pk_bf16_f32 %0, %1, %2" : "=v"(r) : "v"(lo), "v"(hi)); return r; }
__device__ __forceinline__ v4u pack8(const f32x4& a, const f32x4& b) { v4u w; w.x = cvt_pk_bf16(a[0], a[1]); w.y = cvt_pk_bf16(a[2], a[3]); w.z = cvt_pk_bf16(b[0], b[1]); w.w = cvt_pk_bf16(b[2], b[3]); return w; }

__device__ __forceinline__ void epilogue(const Ctx& C, int kind, const Unit& u, f32x4 (&acc)[2][2][4][2], int wr, int wc, int fr, int fq) {
    const int r0 = wr * 64 + fr;
    const int c0 = wc * 32 + fq * 8;
    if (kind == GK_PROJ) {
#pragma unroll
        for (int ai = 0; ai < 2; ++ai)
#pragma unroll
            for (int m = 0; m < 4; ++m) { bf16* rowp = u.Cb + (size_t)(r0 + ai * 128 + m * 16) * u.ldc + c0;
#pragma unroll
                for (int bj = 0; bj < 2; ++bj) *(v4u*)(rowp + bj * 128) = pack8(acc[ai][bj][m][0], acc[ai][bj][m][1]); }
        return;
    }
    if (kind == GK_XPRE) {
#pragma unroll
        for (int ai = 0; ai < 2; ++ai)
#pragma unroll
            for (int m = 0; m < 4; ++m) { unsigned char* rowp = (unsigned char*)u.Cb + (size_t)(r0 + ai * 128 + m * 16) * u.ldc + c0;
#pragma unroll
                for (int bj = 0; bj < 2; ++bj) { const f32x4 a = acc[ai][bj][m][0] * 16.f, b = acc[ai][bj][m][1] * 16.f; v2u o; o.x = pk4_fp8(a[0], a[1], a[2], a[3]); o.y = pk4_fp8(b[0], b[1], b[2], b[3]);
                    *(v2u*)(rowp + bj * 128) = o; } }
        return;
    }
    if (kind == GK_OUT) {
        const float* X = C.p.in[I_X]; bf16* H1B = WSP(bf16, WS_H1B); unsigned char* H1F = WSP(unsigned char, WS_H1F); float* ss1 = (float*)(WSP(unsigned, WS_CTL) + CW_SS1);
#pragma unroll
        for (int ai = 0; ai < 2; ++ai) { f32x4 xv[4][2][2];
#pragma unroll
            for (int m = 0; m < 4; ++m)
#pragma unroll
                for (int bj = 0; bj < 2; ++bj) { const size_t off = (size_t)(u.pm * 256 + r0 + ai * 128 + m * 16) * DM + u.pn * 256 + bj * 128 + c0; xv[m][bj][0] = *(const f32x4*)(X + off); xv[m][bj][1] = *(const f32x4*)(X + off + 4); }
#pragma unroll
            for (int m = 0; m < 4; ++m) { const int row = u.pm * 256 + r0 + ai * 128 + m * 16; float s = 0.f;
#pragma unroll
                for (int bj = 0; bj < 2; ++bj) { const size_t off = (size_t)row * DM + u.pn * 256 + bj * 128 + c0;
                    const f32x4 h0 = xv[m][bj][0] + acc[ai][bj][m][0], h1 = xv[m][bj][1] + acc[ai][bj][m][1];
                    *(v4u*)(H1B + off) = pack8(h0, h1);
                    { const f32x4 a = h0 * 8.f, b = h1 * 8.f; v2u o; o.x = pk4_fp8(a[0], a[1], a[2], a[3]); o.y = pk4_fp8(b[0], b[1], b[2], b[3]); *(v2u*)(H1F + off) = o; }
                    s += (h0[0] * h0[0] + h0[1] * h0[1]) + (h0[2] * h0[2] + h0[3] * h0[3]) + (h1[0] * h1[0] + h1[1] * h1[1]) + (h1[2] * h1[2] + h1[3] * h1[3]); }
                s += __shfl_xor(s, 16); s += __shfl_xor(s, 32);
                if (fq == 0) atomicAdd(ss1 + row, s); } }
        return;
    }
    if (kind == GK_SCORE) {
        const float* ss1 = (const float*)(WSP(unsigned, WS_CTL) + CW_SS1); unsigned char* PB_ = WSP(unsigned char, WS_PBUF);
        LAS float* red = (LAS float*)(C.lds + EPI_OFF);
        float mx[2][4];
#pragma unroll
        for (int ai = 0; ai < 2; ++ai)
#pragma unroll
            for (int m = 0; m < 4; ++m) mx[ai][m] = __hip_atomic_load(ss1 + u.pm * 256 + r0 + ai * 128 + m * 16, RLX_AGENT);
#pragma unroll
        for (int ai = 0; ai < 2; ++ai)
#pragma unroll
            for (int m = 0; m < 4; ++m) { const int rt = r0 + ai * 128 + m * 16;
                const float sc = rsqrtf(mx[ai][m] * (1.f / DM) + EPS) * (0.04419417382415922f * (1.f / 128.f)); float mm = -3.0e38f;
#pragma unroll
                for (int bj = 0; bj < 2; ++bj)
#pragma unroll
                    for (int n = 0; n < 2; ++n) { acc[ai][bj][m][n] *= sc;
#pragma unroll
                        for (int j = 0; j < 4; ++j) mm = fmaxf(mm, acc[ai][bj][m][n][j]); }
                mm = fmaxf(mm, __shfl_xor(mm, 16)); mm = fmaxf(mm, __shfl_xor(mm, 32));
                if (fq == 0) red[rt * 4 + wc] = mm; }
        LDS_WAIT(); __syncthreads();
#pragma unroll
        for (int ai = 0; ai < 2; ++ai)
#pragma unroll
            for (int m = 0; m < 4; ++m) { const int rt = r0 + ai * 128 + m * 16; const f32x4 q = *(const LAS f32x4*)(red + rt * 4);
                const float mm = fmaxf(fmaxf(q[0], q[1]), fmaxf(q[2], q[3])); float s = 0.f;
#pragma unroll
                for (int bj = 0; bj < 2; ++bj)
#pragma unroll
                    for (int n = 0; n < 2; ++n)
#pragma unroll
                        for (int j = 0; j < 4; ++j) { const float e = __expf(acc[ai][bj][m][n][j] - mm); acc[ai][bj][m][n][j] = e; s += e; }
                s += __shfl_xor(s, 16); s += __shfl_xor(s, 32);
                if (fq == 0) red[1024 + rt * 4 + wc] = s; mx[ai][m] = 0.f; }
        LDS_WAIT(); __syncthreads();
#pragma unroll
        for (int ai = 0; ai < 2; ++ai)
#pragma unroll
            for (int m = 0; m < 4; ++m) { const int rt = r0 + ai * 128 + m * 16; const int row = u.pm * 256 + rt; const f32x4 q = *(const LAS f32x4*)(red + 1024 + rt * 4);
                const float inv = 256.f / ((q[0] + q[1]) + (q[2] + q[3]));
#pragma unroll
                for (int bj = 0; bj < 2; ++bj) { const f32x4 p0 = acc[ai][bj][m][0] * inv, p1 = acc[ai][bj][m][1] * inv; v2u o; o.x = pk4_fp8(p0[0], p0[1], p0[2], p0[3]); o.y = pk4_fp8(p1[0], p1[1], p1[2], p1[3]);
                    *(v2u*)(PB_ + (size_t)row * 1024 + u.pn * 256 + bj * 128 + c0) = o; } }
        (void)mx;
        LDS_WAIT(); __syncthreads();
        return;
    }
    if (kind == GK_PV) {
        bf16* H1 = WSP(bf16, WS_H1B); v4u tv[2][4][2];
#pragma unroll
        for (int ai = 0; ai < 2; ++ai)
#pragma unroll
            for (int m = 0; m < 4; ++m)
#pragma unroll
                for (int bj = 0; bj < 2; ++bj) tv[ai][m][bj] = *(const v4u*)(H1 + (size_t)(u.pm * 256 + r0 + ai * 128 + m * 16) * DM + u.pn * 256 + bj * 128 + c0);
#pragma unroll
        for (int ai = 0; ai < 2; ++ai)
#pragma unroll
            for (int m = 0; m < 4; ++m) { const int row = u.pm * 256 + r0 + ai * 128 + m * 16;
#pragma unroll
                for (int bj = 0; bj < 2; ++bj) { const size_t off = (size_t)row * DM + u.pn * 256 + bj * 128 + c0; const v4u t = tv[ai][m][bj];
                    const f32x4 h0 = (f32x4){bf2f(t.x & 0xffffu), bf2f(t.x >> 16), bf2f(t.y & 0xffffu), bf2f(t.y >> 16)} + acc[ai][bj][m][0] * (1.f / 4096.f), h1 = (f32x4){bf2f(t.z & 0xffffu), bf2f(t.z >> 16), bf2f(t.w & 0xffffu), bf2f(t.w >> 16)} + acc[ai][bj][m][1] * (1.f / 4096.f);
                    *(v4u*)(H1 + off) = pack8(h0, h1); } }
        return;
    }
    if (kind == GK_MOE1) {
        unsigned char* HID = WSP(unsigned char, WS_HID);
#pragma unroll
        for (int ai = 0; ai < 2; ++ai)
#pragma unroll
            for (int m = 0; m < 4; ++m) { const int rt = r0 + ai * 128 + m * 16; float h[8];
#pragma unroll
                for (int j = 0; j < 4; ++j) { h[j] = siluf_(acc[ai][0][m][0][j] * WSCALE_INV) * (acc[ai][1][m][0][j] * WSCALE_INV); h[4 + j] = siluf_(acc[ai][0][m][1][j] * WSCALE_INV) * (acc[ai][1][m][1][j] * WSCALE_INV); }
                v2u o; o.x = pk4_fp8(h[0], h[1], h[2], h[3]); o.y = pk4_fp8(h[4], h[5], h[6], h[7]);
                __hip_atomic_store((unsigned long long*)(HID + (size_t)(u.mtg * 256 + rt) * 1024 + u.pn * 128 + c0), ((unsigned long long)o.y << 32) | o.x, RLX_AGENT); }
        return;
    }
    {
        unsigned char* Y = WSP(unsigned char, WS_Y); const int* list = WSP(int, WS_LIST);
        int aids[2][4];
#pragma unroll
        for (int ai = 0; ai < 2; ++ai)
#pragma unroll
            for (int m = 0; m < 4; ++m) { const int slot = u.mtl * 256 + r0 + ai * 128 + m * 16; aids[ai][m] = list[u.e * 8192 + (slot < u.cnt ? slot : u.cnt - 1)]; }
#pragma unroll
        for (int ai = 0; ai < 2; ++ai)
#pragma unroll
            for (int m = 0; m < 4; ++m) { const int rt = r0 + ai * 128 + m * 16; const int slot = u.mtl * 256 + rt;
                if (slot < u.cnt) { const int aid = aids[ai][m];
#pragma unroll
                    for (int bj = 0; bj < 2; ++bj) { const f32x4 a = acc[ai][bj][m][0] * WSCALE_INV, b = acc[ai][bj][m][1] * WSCALE_INV; v2u o; o.x = pk4_fp8(a[0], a[1], a[2], a[3]); o.y = pk4_fp8(b[0], b[1], b[2], b[3]);
                        *(v2u*)(Y + (size_t)aid * DM + u.pn * 256 + bj * 128 + c0) = o; } } }
    }
}

__device__ __forceinline__ void moe_tables(const Ctx& C) {
    LAS int* ts = (LAS int*)(C.lds + TBL_OFF); LAS int* cn = ts + 40;
    if (C.wave == 0) { const unsigned* cnt = WSP(unsigned, WS_CTL) + CW_CNT; const int l5 = C.lane & 31;
        const int c = (int)__hip_atomic_load(cnt + l5 * 64, RLX_AGENT); const int nt = (c + 255) >> 8; int incl = nt;
#pragma unroll
        for (int d = 1; d < 32; d <<= 1) { const int t = __shfl_up(incl, d); if (l5 >= d) incl += t; }
        if (C.lane < 32) { cn[C.lane] = c; ts[C.lane] = incl - nt; if (C.lane == 31) ts[32] = incl; } }
    LDS_WAIT(); __syncthreads();
}

constexpr int HTB = 128 * 64 * 2;
__device__ __forceinline__ int lds_byte(int r, int c) { const int st = (r >> 4) * 2 + (c >> 5), rr = r & 15, cc = c & 31, ob = rr * 64 + cc * 2; return st * 1024 + (ob ^ (((ob >> 9) & 1) << 5)); }
__device__ __forceinline__ void stage_rc(int b, int& R, int& Cc) { const int st = b / 1024, sb = b % 1024, swz = sb ^ (((sb >> 9) & 1) << 5); R = (st >> 1) * 16 + swz / 64; Cc = (st & 1) * 32 + (swz % 64) / 2; }
__device__ __forceinline__ int perm32(int rho) { const int n = rho >> 4, i = rho & 15; return 8 * (i >> 2) + 4 * n + (i & 3); }

__device__ __forceinline__ v8i mk8(bf16x8 lo, bf16x8 hi) { const v4i a = __builtin_bit_cast(v4i, lo), b = __builtin_bit_cast(v4i, hi); return __builtin_shufflevector(a, b, 0, 1, 2, 3, 4, 5, 6, 7); }
template <int KIND>
__device__ __forceinline__ void gemm_phase_fast(const Ctx& C) {
    constexpr bool GATHER = (KIND == GK_MOE1);
    constexpr bool MX = (KIND == GK_MOE1 || KIND == GK_MOE2 || KIND == GK_SCORE || KIND == GK_PV);
    const int tid = C.tid, wid = C.wave, lane = C.lane, wr = wid >> 2, wc = wid & 3, fr = lane & 15, fq = lane >> 4;
    LAS unsigned char* lds = C.lds;
    if (KIND == GK_MOE1) moe_tables(C);
    constexpr int K = (KIND == GK_XPRE) ? 512 : ((KIND == GK_PV || KIND == GK_MOE2) ? 1024 : 2048);
    constexpr int nt = MX ? K / 128 : K / 64;
    Unit cur, nxt; int ui = 0;
    if (!unit_next(C, KIND, 0, cur)) return;
    int Rs[2], Cs[2];
#pragma unroll
    for (int i = 0; i < 2; ++i) stage_rc(tid * 16 + i * 8192, Rs[i], Cs[i]);
    unsigned voffB[2], voffA[2];
#pragma unroll
    for (int i = 0; i < 2; ++i) { const int Rb = (Rs[i] & ~31) + perm32(Rs[i] & 31); voffB[i] = (unsigned)Rb * cur.ldb2 + (unsigned)Cs[i] * 2u; voffA[i] = (unsigned)Rs[i] * cur.lda2 + (unsigned)Cs[i] * 2u; }
    unsigned gA[2][2], gAn[2][2];
    if constexpr (GATHER) {
#pragma unroll
        for (int h = 0; h < 2; ++h)
#pragma unroll
            for (int i = 0; i < 2; ++i) { gA[h][i] = a_row_off(C, KIND, cur, h * 128 + Rs[i]) + (unsigned)Cs[i] * 2u; gAn[h][i] = gA[h][i]; }
    }
    const size_t hstepA = GATHER ? 0 : (size_t)128 * cur.lda2, hstepB = (size_t)128 * cur.ldb2;
    constexpr size_t kstep = 128;
    const unsigned ldsw = (unsigned)wid * 1024u;
    const int aoff = lds_byte(wr * 64 + fr, fq * 8), boff = lds_byte(wc * 32 + fr, fq * 8);
#define G_SA(b, h) (((b) * 2 + (h)) * HTB)
#define G_SB(b, h) ((4 + (b) * 2 + (h)) * HTB)
#define G_STAGE(bufoff, gbase, voff) do { _Pragma("unroll") for (int _i = 0; _i < 2; ++_i) \
        __builtin_amdgcn_global_load_lds((const unsigned*)((const char*)(gbase) + (voff)[_i]), (LAS unsigned*)(lds + (bufoff) + ldsw + _i * 8192), 16, 0, 0); } while (0)
#define G_STAGE_A(bufoff, ab, go, h, kb) do { if constexpr (GATHER) { G_STAGE(bufoff, (ab) + (kb), (go)[h]); } else { G_STAGE(bufoff, (ab) + (size_t)(h) * hstepA + (kb), voffA); } } while (0)
#define G_LDA(dst, b, h) do { if constexpr (MX) { _Pragma("unroll") for (int m = 0; m < 4; ++m) dst##8[m] = mk8(*(const LAS bf16x8*)(lds + G_SA(b, h) + aoff + m * 2048), *(const LAS bf16x8*)(lds + G_SA(b, h) + aoff + m * 2048 + 1024)); } \
        else { _Pragma("unroll") for (int m = 0; m < 4; ++m) _Pragma("unroll") for (int k = 0; k < 2; ++k) dst[m][k] = *(const LAS bf16x8*)(lds + G_SA(b, h) + aoff + m * 2048 + k * 1024); } } while (0)
#define G_LDB(dst, b, h) do { if constexpr (MX) { _Pragma("unroll") for (int n = 0; n < 2; ++n) dst##8[n] = mk8(*(const LAS bf16x8*)(lds + G_SB(b, h) + boff + n * 2048), *(const LAS bf16x8*)(lds + G_SB(b, h) + boff + n * 2048 + 1024)); } \
        else { _Pragma("unroll") for (int n = 0; n < 2; ++n) _Pragma("unroll") for (int k = 0; k < 2; ++k) dst[n][k] = *(const LAS bf16x8*)(lds + G_SB(b, h) + boff + n * 2048 + k * 1024); } } while (0)
#define G_MMA(ai, bj, At, Bt) do { __builtin_amdgcn_s_setprio(1); _Pragma("unroll") for (int m = 0; m < 4; ++m) _Pragma("unroll") for (int n = 0; n < 2; ++n) { \
        if constexpr (MX) { asm volatile("s_nop 1\n\tv_mfma_scale_f32_16x16x128_f8f6f4 %0, %1, %2, %0, %3, %3 op_sel_hi:[0,0,0]" : "+v"(acc[ai][bj][m][n]) : "v"(Bt##8[n]), "v"(At##8[m]), "v"(mxs)); } \
        else { _Pragma("unroll") for (int k = 0; k < 2; ++k) acc[ai][bj][m][n] = __builtin_amdgcn_mfma_f32_16x16x32_bf16(Bt[n][k], At[m][k], acc[ai][bj][m][n], 0, 0, 0); } } \
        __builtin_amdgcn_s_setprio(0); } while (0)
#define G_WAIT_V(n) asm volatile("s_waitcnt vmcnt(" #n ")" ::: "memory")
#define G_WAIT_L(n) asm volatile("s_waitcnt lgkmcnt(" #n ")" ::: "memory")
#define G_BAR __builtin_amdgcn_s_barrier()
#define G_SCHED __builtin_amdgcn_sched_barrier(0)
    f32x4 acc[2][2][4][2];
#pragma unroll
    for (int a = 0; a < 2; ++a)
#pragma unroll
        for (int b = 0; b < 2; ++b)
#pragma unroll
            for (int m = 0; m < 4; ++m)
#pragma unroll
                for (int n = 0; n < 2; ++n) acc[a][b][m][n] = (f32x4){0.f, 0.f, 0.f, 0.f};
    bf16x8 At[4][2], B0[2][2], B1[2][2];
    v8i At8[4], B08[2], B18[2];
    int mxs = 0x7f7f7f7f; asm volatile("" : "+v"(mxs));
    const char* cA = cur.A; const char* cB = cur.B;
    G_STAGE(G_SB(0, 0), cB, voffB); G_STAGE(G_SB(0, 1), cB + hstepB, voffB); G_STAGE_A(G_SA(0, 0), cA, gA, 0, 0); G_STAGE_A(G_SA(0, 1), cA, gA, 1, 0);
    if (wr == 1) G_BAR;
    G_WAIT_V(2); G_BAR;
    G_STAGE(G_SB(1, 0), cB + kstep, voffB); G_STAGE_A(G_SA(1, 0), cA, gA, 0, kstep); G_STAGE(G_SB(1, 1), cB + hstepB + kstep, voffB);
    G_WAIT_V(6); G_BAR;
    for (;;) {
        const bool has_next = unit_next(C, KIND, ui + 1, nxt);
        const char* nA = has_next ? nxt.A : cA; const char* nB = has_next ? nxt.B : cB;
        if constexpr (GATHER) { if (has_next) {
#pragma unroll
            for (int h = 0; h < 2; ++h)
#pragma unroll
                for (int i = 0; i < 2; ++i) gAn[h][i] = a_row_off(C, KIND, nxt, h * 128 + Rs[i]) + (unsigned)Cs[i] * 2u; } }
        bool skip1 = false;
        if constexpr (KIND == GK_MOE1 || KIND == GK_MOE2) skip1 = (cur.cnt - cur.mtl * 256) <= 128;
#pragma nounroll
        for (int t = 0; t < nt; t += 2) {
            const bool last = (t == nt - 2);
            const char* a2 = last ? nA : cA + (size_t)(t + 2) * kstep; const char* b2 = last ? nB : cB + (size_t)(t + 2) * kstep;
            unsigned g2[2][2];
            if constexpr (GATHER) {
#pragma unroll
                for (int h = 0; h < 2; ++h)
#pragma unroll
                    for (int i = 0; i < 2; ++i) g2[h][i] = last ? gAn[h][i] : gA[h][i]; }
            G_LDB(B0, 0, 0); G_LDB(B1, 0, 1); G_SCHED; G_LDA(At, 0, 0); G_STAGE_A(G_SA(1, 1), cA, gA, 1, (size_t)(t + 1) * kstep);
            G_WAIT_V(8); G_WAIT_L(0); G_BAR; G_MMA(0, 0, At, B0); G_MMA(0, 1, At, B1); G_BAR; G_SCHED;
            if (!skip1) G_LDA(At, 0, 1); G_STAGE(G_SB(0, 0), b2, voffB); G_STAGE(G_SB(0, 1), b2 + hstepB, voffB); G_STAGE_A(G_SA(0, 0), a2, g2, 0, 0);
            G_WAIT_V(8); G_WAIT_L(0); G_BAR; if (!skip1) { G_MMA(1, 0, At, B0); G_MMA(1, 1, At, B1); } G_BAR; G_SCHED;
            G_LDB(B0, 1, 0); G_LDB(B1, 1, 1); G_SCHED; G_LDA(At, 1, 0); G_STAGE_A(G_SA(0, 1), a2, g2, 1, 0);
            G_WAIT_V(8); G_WAIT_L(0); G_BAR; G_MMA(0, 0, At, B0); G_MMA(0, 1, At, B1); G_BAR; G_SCHED;
            if (!skip1) G_LDA(At, 1, 1); G_STAGE(G_SB(1, 0), b2 + kstep, voffB); G_STAGE(G_SB(1, 1), b2 + kstep + hstepB, voffB); G_STAGE_A(G_SA(1, 0), a2, g2, 0, kstep);
            G_WAIT_V(8); G_WAIT_L(0); G_BAR; if (!skip1) { G_MMA(1, 0, At, B0); G_MMA(1, 1, At, B1); } G_BAR; G_SCHED;
        }
        if (wr == 0) G_BAR;
        if constexpr (MX) asm volatile("s_nop 15\n\ts_nop 15" ::: "memory");
        { int te = threadIdx.x; asm volatile("" : "+v"(te));
          const int el = te & 63, ew = __builtin_amdgcn_readfirstlane(te >> 6); epilogue(C, KIND, cur, acc, ew >> 2, ew & 3, el & 15, el >> 4); }
        if constexpr (KIND == GK_MOE1) {
            G_WAIT_V(0); G_BAR;
            if (tid == 0) __hip_atomic_fetch_add(WSP(unsigned, WS_CTL) + CW_MT + 16 * cur.mtg, 1u, RLX_AGENT); }
        if (!has_next) break;
#pragma unroll
        for (int a = 0; a < 2; ++a)
#pragma unroll
            for (int b = 0; b < 2; ++b)
#pragma unroll
                for (int m = 0; m < 4; ++m)
#pragma unroll
                    for (int n = 0; n < 2; ++n) acc[a][b][m][n] = (f32x4){0.f, 0.f, 0.f, 0.f};
        cur = nxt; cA = nA; cB = nB; ++ui;
        if constexpr (GATHER) {
#pragma unroll
            for (int h = 0; h < 2; ++h)
#pragma unroll
                for (int i = 0; i < 2; ++i) gA[h][i] = gAn[h][i]; }
        if (wr == 1) G_BAR;
    }
    G_WAIT_V(0);
    G_BAR;
#undef G_SA
#undef G_SB
#undef G_STAGE
#undef G_STAGE_A
#undef G_LDA
#undef G_LDB
#undef G_MMA
#undef G_WAIT_V
#undef G_WAIT_L
#undef G_BAR
#undef G_SCHED
}

__device__ __forceinline__ void la_phase_scan(const Ctx& C) {
    const int g = blockIdx.x * 512 + C.tid;
    bf16* base; const float* db; size_t cstride, dstride;
    if (g < 65536) { const int d4 = g & 31, v = (g >> 5) & 255, h = (g >> 13) & 3, b = g >> 15;
        base = WSP(bf16, WS_UT) + ((size_t)(b * 64 * 4 + h) * 256 + v) * 128 + d4 * 4; cstride = (size_t)4 * 256 * 128;
        db = WSP(float, WS_DB) + (size_t)(b * 64 * 4 + h) * 128 + d4 * 4; dstride = 4 * 128; }
    else { const int g2 = g - 65536; const int d4 = g2 & 31, v = (g2 >> 5) & 127, h = (g2 >> 12) & 7, b = g2 >> 15;
        base = WSP(bf16, WS_UT) + (size_t)128 * 4 * 256 * 128 + ((size_t)(b * 64 * 8 + h) * 128 + v) * 128 + d4 * 4; cstride = (size_t)8 * 128 * 128;
        db = WSP(float, WS_DB) + 128 * 4 * 128 + (size_t)(b * 64 * 8 + h) * 128 + d4 * 4; dstride = 8 * 128; }
    float S[4] = {0.f, 0.f, 0.f, 0.f};
    for (int c0 = 0; c0 < 64; c0 += 8) {
        v2u uu[8]; f32x4 dd[8];
#pragma unroll
        for (int j = 0; j < 8; ++j) { uu[j] = *(const v2u*)(base + (size_t)(c0 + j) * cstride); dd[j] = *(const f32x4*)(db + (size_t)(c0 + j) * dstride); }
#pragma unroll
        for (int j = 0; j < 8; ++j) { v2u o; o.x = pk2(S[0], S[1]); o.y = pk2(S[2], S[3]); *(v2u*)(base + (size_t)(c0 + j) * cstride) = o;
            S[0] = dd[j][0] * S[0] + bf2f(uu[j].x & 0xffffu); S[1] = dd[j][1] * S[1] + bf2f(uu[j].x >> 16);
            S[2] = dd[j][2] * S[2] + bf2f(uu[j].y & 0xffffu); S[3] = dd[j][3] * S[3] + bf2f(uu[j].y >> 16); }
    }
}
__device__ __forceinline__ bf16x8 ld_frag(const LAS unsigned char* base, int stride, int row0, int ks, int lane) {
    return *(const LAS bf16x8*)(base + (row0 + (lane & 15)) * stride + (32 * ks + 8 * (lane >> 4)) * 2);
}
template <int DV>
__device__ __forceinline__ void load_vT_regs(const Ctx& C, const bf16* vsrc  , v4u (&r)[DV / 64]) {
    const int lane = C.lane, tl = lane & 15, v8l = lane >> 4;
#pragma unroll
    for (int it = 0; it < DV / 64; ++it) { const int blk = C.wave * (DV / 64) + it; const int tb = blk & 3, vb = blk >> 2; const int t = tb * 16 + tl, v8 = vb * 4 + v8l;
        r[it] = *(const v4u*)(vsrc + (size_t)t * PBLD + v8 * 8); }
}
template <int DV>
__device__ __forceinline__ void store_vT_regs(const Ctx& C, LAS unsigned char* VR, const v4u (&r)[DV / 64]) {
    const int lane = C.lane, tl = lane & 15, v8l = lane >> 4;
#pragma unroll
    for (int it = 0; it < DV / 64; ++it) { const int blk = C.wave * (DV / 64) + it; const int tb = blk & 3, vb = blk >> 2; const int t = tb * 16 + tl, v8 = vb * 4 + v8l;
        *(LAS v4u*)(VR + t * (DV * 2 + 16) + v8 * 16) = r[it]; }
}
typedef short v4s __attribute__((ext_vector_type(4)));
template <int DV>
__device__ __forceinline__ bf16x8 ld_frag_tr(const LAS unsigned char* VR, int v0, int ks, int lane) {
    const int g = lane >> 4, i = lane & 15, q = i >> 2, p = i & 3;
    const LAS unsigned char* a0 = VR + (32 * ks + 8 * g + q) * (DV * 2 + 16) + (v0 + 4 * p) * 2;
    const v4s lo = __builtin_amdgcn_ds_read_tr16_b64_v4i16((LAS v4s*)a0), hi = __builtin_amdgcn_ds_read_tr16_b64_v4i16((LAS v4s*)(a0 + 4 * (DV * 2 + 16)));
    return (bf16x8){lo[0], lo[1], lo[2], lo[3], hi[0], hi[1], hi[2], hi[3]};
}
template <int DV> struct PaRegs { v4u vr[DV / 64]; unsigned gt[16], qv[16], kv[16]; float c0, c1; };
template <int DV, bool GLA>
__device__ __forceinline__ void pa_load(const Ctx& C, int bc, int h, PaRegs<DV>& R) {
    const int tid = C.tid, d = tid & 127, sg = tid >> 7; const int t0 = bc * 64;
    const bf16* PB = WSP(bf16, WS_PB);
    const int qcol = (GLA ? C_GQ : C_HQ) + h * 128, kcol = (GLA ? C_GK : C_HK) + h * 128, vcol = (GLA ? C_GV : C_HV) + h * DV;
    load_vT_regs<DV>(C, PB + pb_off(t0, vcol), R.vr);
    if (GLA) { R.c0 = C.p.in[I_BALPHA][h * 128 + d]; R.c1 = 0.f; } else { const float* lg = C.p.in[I_LBLOG]; R.c0 = lg[h * 128 + d]; R.c1 = lg[1024 + h * 128 + d]; }
    const bf16* gp = PB + pb_off(t0 + sg * 16, (GLA ? C_GA : C_HK) + h * 128) + d;
    const bf16* pq = PB + pb_off(t0 + sg * 16, qcol) + d; const bf16* pk = PB + pb_off(t0 + sg * 16, kcol) + d;
#pragma unroll
    for (int i = 0; i < 16; ++i) { R.gt[i] = __builtin_nontemporal_load(gp + i * PBLD); R.qv[i] = __builtin_nontemporal_load(pq + i * PBLD); if (GLA) R.kv[i] = __builtin_nontemporal_load(pk + i * PBLD); }
}
template <int DV, bool GLA>
__device__ __forceinline__ void pa_part1(const Ctx& C, int bc, int h, const PaRegs<DV>& R) {
    const int tid = C.tid, d = tid & 127, sg = tid >> 7;
    LAS unsigned char* kT = C.lds;
    LAS unsigned char* VT = C.lds + 18432;
    LAS float* seg = (LAS float*)(C.lds + 18432 + 36864);
    LAS float* Dl  = seg + 512;
    const int t0 = bc * 64;
    bf16* PB = WSP(bf16, WS_PB);
    const int qcol = (GLA ? C_GQ : C_HQ) + h * 128, kcol = (GLA ? C_GK : C_HK) + h * 128;
    constexpr float qscale = GLA ? 0.08838834764831845f : 1.0f;
    store_vT_regs<DV>(C, VT, R.vr);
    float gt[16], qf[16], kf[16];
    { float lb = 0.f, ba = 0.f; if (GLA) ba = R.c0; else lb = 1.f / (1.f + __expf(R.c1 - R.c0));
#pragma unroll
      for (int i = 0; i < 16; ++i) { const float q = bf2f(R.qv[i]);
          if (GLA) { gt[i] = logsigmoidf_(bf2f(R.gt[i]) + ba) * 0.0625f; qf[i] = q; kf[i] = bf2f(R.kv[i]); }
          else { const float z = fminf(fmaxf(bf2f(R.gt[i]), -30.f), 30.f), ez = __expf(-z), sg = 1.f / (1.f + ez);
                 gt[i] = __logf(lb + (1.f - lb) * sg); kf[i] = (1.f - lb) * ez * sg; qf[i] = siluf_(q); } } }
    float run = 0.f;
#pragma unroll
    for (int i = 0; i < 16; ++i) run += gt[i];
    seg[sg * 128 + d] = run;
    LDS_WAIT(); __syncthreads();
    float b = 0.f;
    for (int s = 0; s < sg; ++s) b += seg[s * 128 + d];
    { bf16* pq = PB + pb_off(t0 + sg * 16, qcol) + d; bf16* pk = PB + pb_off(t0 + sg * 16, kcol) + d;
#pragma unroll
      for (int hh = 0; hh < 2; ++hh) { unsigned kk[8];
#pragma unroll
        for (int i = 0; i < 8; ++i) {
            b += gt[hh * 8 + i];
            const unsigned qt = f2bf(qf[hh * 8 + i] * qscale * __expf(b)), kt = f2bf(kf[hh * 8 + i] * __expf(-b));
            pq[(hh * 8 + i) * PBLD] = (bf16)qt; pk[(hh * 8 + i) * PBLD] = (bf16)kt; kk[i] = kt; }
        v4u w; w.x = kk[0] | (kk[1] << 16); w.y = kk[2] | (kk[3] << 16); w.z = kk[4] | (kk[5] << 16); w.w = kk[6] | (kk[7] << 16);
        *(LAS v4u*)(kT + d * 144 + (sg * 16 + hh * 8) * 2) = w; }
      if (sg == 3) { const float dd = __expf(b); Dl[d] = dd; (GLA ? WSP(float, WS_DB) + (size_t)(bc * 4 + h) * 128 : WSP(float, WS_DB) + 128 * 4 * 128 + (size_t)(bc * 8 + h) * 128)[d] = dd; } }
}
template <int DV, bool GLA>
__device__ __forceinline__ void pa_part2(const Ctx& C, int bc, int h) {
    const int lane = C.lane;
    LAS unsigned char* kT = C.lds; LAS unsigned char* VT = C.lds + 18432; LAS float* Dl = (LAS float*)(C.lds + 18432 + 36864) + 512;
    LDS_WAIT(); __syncthreads();
    { const int dt = C.wave; bf16* UT = GLA ? WSP(bf16, WS_UT) + (size_t)(bc * 4 + h) * 256 * 128 : WSP(bf16, WS_UT) + (size_t)128 * 4 * 256 * 128 + (size_t)(bc * 8 + h) * 128 * 128;
      const bf16x8 k0 = ld_frag(kT, 144, dt * 16, 0, lane), k1 = ld_frag(kT, 144, dt * 16, 1, lane);
      const f32x4 dd = *(const LAS f32x4*)(Dl + dt * 16 + 4 * (lane >> 4));
      for (int v4 = 0; v4 < DV / 64; ++v4) { bf16x8 f0[4], f1[4]; f32x4 acc[4];
#pragma unroll
          for (int j = 0; j < 4; ++j) { f0[j] = ld_frag_tr<DV>(VT, (v4 * 4 + j) * 16, 0, lane); f1[j] = ld_frag_tr<DV>(VT, (v4 * 4 + j) * 16, 1, lane); }
#pragma unroll
          for (int j = 0; j < 4; ++j) acc[j] = __builtin_amdgcn_mfma_f32_16x16x32_bf16(k0, f0[j], (f32x4){0.f, 0.f, 0.f, 0.f}, 0, 0, 0);
#pragma unroll
          for (int j = 0; j < 4; ++j) acc[j] = __builtin_amdgcn_mfma_f32_16x16x32_bf16(k1, f1[j], acc[j], 0, 0, 0);
#pragma unroll
          for (int j = 0; j < 4; ++j) { v2u o; o.x = pk2(acc[j][0] * dd[0], acc[j][1] * dd[1]); o.y = pk2(acc[j][2] * dd[2], acc[j][3] * dd[3]);
              *(v2u*)(UT + (size_t)((v4 * 4 + j) * 16 + (lane & 15)) * 128 + dt * 16 + 4 * (lane >> 4)) = o; } } }
    LDS_WAIT(); __syncthreads();
}
__device__ __forceinline__ void la2_phase_a(const Ctx& C) {
    const int w = blockIdx.x, bc = w >> 1, half = w & 1;
    PaRegs<256> g0, g1; PaRegs<128> h0, h1, h2, h3;
#define SB_ __builtin_amdgcn_sched_barrier(0)
    pa_load<256, true>(C, bc, half * 2 + 0, g0); SB_;
    pa_load<256, true>(C, bc, half * 2 + 1, g1); SB_; pa_part1<256, true>(C, bc, half * 2 + 0, g0); pa_part2<256, true>(C, bc, half * 2 + 0); SB_;
    pa_load<128, false>(C, bc, half * 4 + 0, h0); SB_; pa_part1<256, true>(C, bc, half * 2 + 1, g1); pa_part2<256, true>(C, bc, half * 2 + 1); SB_;
    pa_load<128, false>(C, bc, half * 4 + 1, h1); SB_; pa_part1<128, false>(C, bc, half * 4 + 0, h0); pa_part2<128, false>(C, bc, half * 4 + 0); SB_;
    pa_load<128, false>(C, bc, half * 4 + 2, h2); SB_; pa_part1<128, false>(C, bc, half * 4 + 1, h1); pa_part2<128, false>(C, bc, half * 4 + 1); SB_;
    pa_load<128, false>(C, bc, half * 4 + 3, h3); SB_; pa_part1<128, false>(C, bc, half * 4 + 2, h2); pa_part2<128, false>(C, bc, half * 4 + 2); SB_;
    pa_part1<128, false>(C, bc, half * 4 + 3, h3); pa_part2<128, false>(C, bc, half * 4 + 3);
#undef SB_
}
template <int DV> struct PcRegs { v4u qr[2], kr[2], sr[DV / 32], vr[DV / 64]; };
template <int DV, bool GLA>
__device__ __forceinline__ void pc_load(const Ctx& C, int bc, int h, PcRegs<DV>& R) {
    const int tid = C.tid; const int t0 = bc * 64; const bf16* PB = WSP(bf16, WS_PB);
    const int qcol = (GLA ? C_GQ : C_HQ) + h * 128, kcol = (GLA ? C_GK : C_HK) + h * 128, vcol = (GLA ? C_GV : C_HV) + h * DV;
    const bf16* ST = GLA ? WSP(bf16, WS_UT) + (size_t)(bc * 4 + h) * 256 * 128 : WSP(bf16, WS_UT) + (size_t)128 * 4 * 256 * 128 + (size_t)(bc * 8 + h) * 128 * 128;
#pragma unroll
    for (int it = 0; it < 2; ++it) { const int idx = tid + it * 512; const int t = idx >> 4, c8 = idx & 15;
        R.qr[it] = __builtin_nontemporal_load((const v4u*)(PB + pb_off(t0 + t, qcol) + c8 * 8)); R.kr[it] = __builtin_nontemporal_load((const v4u*)(PB + pb_off(t0 + t, kcol) + c8 * 8)); }
#pragma unroll
    for (int it = 0; it < DV / 32; ++it) { const int idx = tid + it * 512; const int v = idx >> 4, c8 = idx & 15; R.sr[it] = __builtin_nontemporal_load((const v4u*)(ST + (size_t)v * 128 + c8 * 8)); }
    load_vT_regs<DV>(C, PB + pb_off(t0, vcol), R.vr);
}
template <int DV, bool GLA>
__device__ __forceinline__ void pc_part1(const Ctx& C, const PcRegs<DV>& R) {
    const int tid = C.tid;
    LAS unsigned char* qL = C.lds; LAS unsigned char* kL = C.lds + 17408; LAS unsigned char* VT = C.lds + 34816; LAS unsigned char* sL = C.lds + 34816 + 36864;
#pragma unroll
    for (int it = 0; it < 2; ++it) { const int idx = tid + it * 512; const int t = idx >> 4, c8 = idx & 15;
        *(LAS v4u*)(qL + t * 272 + c8 * 16) = R.qr[it]; *(LAS v4u*)(kL + t * 272 + c8 * 16) = R.kr[it]; }
#pragma unroll
    for (int it = 0; it < DV / 32; ++it) { const int idx = tid + it * 512; const int v = idx >> 4, c8 = idx & 15; *(LAS v4u*)(sL + v * 272 + c8 * 16) = R.sr[it]; }
    store_vT_regs<DV>(C, VT, R.vr);
}
template <int DV, bool GLA>
__device__ __forceinline__ void pc_part2(const Ctx& C, int bc, int h) {
    const int lane = C.lane, w = C.wave;
    LAS unsigned char* qL = C.lds;
    LAS unsigned char* kL = C.lds + 17408;
    LAS unsigned char* VT = C.lds + 34816;
    LAS unsigned char* sL = C.lds + 34816 + 36864;
    LAS unsigned char* AL = C.lds + 71680 + 69632;
    LAS float* red = (LAS float*)(C.lds + 141312 + 9216);
    const int t0 = bc * 64;
    const bf16* PB = WSP(bf16, WS_PB);
    const int gcol = (GLA ? C_GG : C_HG) + h * DV;
    constexpr int NV = DV / 32;
    v2u gts[NV];
    { const int tt_ = w & 3, vh_ = w >> 2, t_ = tt_ * 16 + (lane & 15);
#pragma unroll
      for (int n = 0; n < NV; ++n) { const int v0 = (vh_ * NV + n) * 16 + 4 * (lane >> 4); gts[n] = *(const v2u*)(PB + pb_off(t0 + t_, gcol) + v0); } }
    __builtin_amdgcn_sched_barrier(0);
    LDS_WAIT(); __syncthreads();
    { const int it = w & 3, jt0 = (w >> 2) * 2; f32x4 a2[2] = {{0.f, 0.f, 0.f, 0.f}, {0.f, 0.f, 0.f, 0.f}};
      if (jt0 <= it) {
#pragma unroll
          for (int ks = 0; ks < 4; ++ks) { const bf16x8 qf = ld_frag(qL, 272, it * 16, ks, lane), k0 = ld_frag(kL, 272, jt0 * 16, ks, lane), k1 = ld_frag(kL, 272, jt0 * 16 + 16, ks, lane);
              a2[0] = __builtin_amdgcn_mfma_f32_16x16x32_bf16(k0, qf, a2[0], 0, 0, 0); a2[1] = __builtin_amdgcn_mfma_f32_16x16x32_bf16(k1, qf, a2[1], 0, 0, 0); } }
#pragma unroll
      for (int jj = 0; jj < 2; ++jj) { const int jt = jt0 + jj; const f32x4 acc = a2[jj];
          const int i = it * 16 + (lane & 15), j0 = jt * 16 + 4 * (lane >> 4);
          v2u o; o.x = pk2(j0 + 0 <= i ? acc[0] : 0.f, j0 + 1 <= i ? acc[1] : 0.f); o.y = pk2(j0 + 2 <= i ? acc[2] : 0.f, j0 + 3 <= i ? acc[3] : 0.f);
          *(LAS v2u*)(AL + i * 144 + j0 * 2) = o; } }
    LDS_WAIT(); __syncthreads();
    const int tt = w & 3, vh = w >> 2;
    f32x4 o[NV];
    { bf16x8 af[2], qf[4];
#pragma unroll
      for (int ks = 0; ks < 2; ++ks) af[ks] = ld_frag(AL, 144, tt * 16, ks, lane);
#pragma unroll
      for (int ks = 0; ks < 4; ++ks) qf[ks] = ld_frag(qL, 272, tt * 16, ks, lane);
#pragma unroll
      for (int n = 0; n < NV; ++n) o[n] = (f32x4){0.f, 0.f, 0.f, 0.f};
#pragma unroll
      for (int ks = 0; ks < 2; ++ks) { bf16x8 vf[NV];
#pragma unroll
          for (int n = 0; n < NV; ++n) vf[n] = ld_frag_tr<DV>(VT, (vh * NV + n) * 16, ks, lane);
#pragma unroll
          for (int n = 0; n < NV; ++n) o[n] = __builtin_amdgcn_mfma_f32_16x16x32_bf16(vf[n], af[ks], o[n], 0, 0, 0); }
#pragma unroll
      for (int ks = 0; ks < 4; ++ks) { bf16x8 sf[NV];
#pragma unroll
          for (int n = 0; n < NV; ++n) sf[n] = ld_frag(sL, 272, (vh * NV + n) * 16, ks, lane);
#pragma unroll
          for (int n = 0; n < NV; ++n) o[n] = __builtin_amdgcn_mfma_f32_16x16x32_bf16(sf[n], qf[ks], o[n], 0, 0, 0); } }
    { float s = 0.f;
#pragma unroll
      for (int n = 0; n < NV; ++n) s += (o[n][0] * o[n][0] + o[n][1] * o[n][1]) + (o[n][2] * o[n][2] + o[n][3] * o[n][3]);
      s += __shfl_xor(s, 16); s += __shfl_xor(s, 32);
      if (lane < 16) red[(tt * 16 + lane) * 2 + vh] = s; }
    LDS_WAIT(); __syncthreads();
    { const int t = tt * 16 + (lane & 15); const f32x2 rr = *(const LAS f32x2*)(red + t * 2); const float rstd = rsqrtf((rr[0] + rr[1]) * (1.f / DV) + EPS);
      const float* gn = GLA ? C.p.in[I_GLAG] : C.p.in[I_HGRNG]; bf16* ON = WSP(bf16, WS_ON); const int ocol = GLA ? h * 256 : 1024 + h * 128;
      f32x4 g4s[NV];
#pragma unroll
      for (int n = 0; n < NV; ++n) g4s[n] = *(const f32x4*)(gn + (vh * NV + n) * 16 + 4 * (lane >> 4));
#pragma unroll
      for (int n = 0; n < NV; ++n) { const int v0 = (vh * NV + n) * 16 + 4 * (lane >> 4); const f32x4 g4 = g4s[n];
          const v2u gt = gts[n];
          v2u ow; ow.x = pk2(o[n][0] * rstd * g4[0] * siluf_(bf2f(gt.x & 0xffffu)), o[n][1] * rstd * g4[1] * siluf_(bf2f(gt.x >> 16)));
          ow.y = pk2(o[n][2] * rstd * g4[2] * siluf_(bf2f(gt.y & 0xffffu)), o[n][3] * rstd * g4[3] * siluf_(bf2f(gt.y >> 16)));
          *(v2u*)(ON + (size_t)(t0 + t) * DM + ocol + v0) = ow; } }
    LDS_WAIT(); __syncthreads();
}
__device__ __forceinline__ void la2_phase_c(const Ctx& C) {
    const int w = blockIdx.x, bc = w >> 1, half = w & 1;
    PcRegs<256> g0, g1; PcRegs<128> h0, h1, h2, h3;
#define SB_ __builtin_amdgcn_sched_barrier(0)
    pc_load<256, true>(C, bc, half * 2 + 0, g0); SB_;
    pc_load<256, true>(C, bc, half * 2 + 1, g1); SB_; pc_part1<256, true>(C, g0); pc_part2<256, true>(C, bc, half * 2 + 0); SB_;
    pc_load<128, false>(C, bc, half * 4 + 0, h0); SB_; pc_part1<256, true>(C, g1); pc_part2<256, true>(C, bc, half * 2 + 1); SB_;
    pc_load<128, false>(C, bc, half * 4 + 1, h1); SB_; pc_part1<128, false>(C, h0); pc_part2<128, false>(C, bc, half * 4 + 0); SB_;
    pc_load<128, false>(C, bc, half * 4 + 2, h2); SB_; pc_part1<128, false>(C, h1); pc_part2<128, false>(C, bc, half * 4 + 1); SB_;
    pc_load<128, false>(C, bc, half * 4 + 3, h3); SB_; pc_part1<128, false>(C, h2); pc_part2<128, false>(C, bc, half * 4 + 2); SB_;
    pc_part1<128, false>(C, h3); pc_part2<128, false>(C, bc, half * 4 + 3);
#undef SB_
}

__device__ __forceinline__ void router_phase(const Ctx& C) {
    const int r0 = blockIdx.x * 32, lane = C.lane, w = C.wave;
    LAS float* rs = (LAS float*)C.lds;
    LAS float* part = (LAS float*)(C.lds + 256);
    const bf16* H2 = WSP(bf16, WS_H1B); const float* g3 = C.p.in[I_NFFNG]; unsigned char* A3F = WSP(unsigned char, WS_A1B);
    { v2u tb[4][8];
#pragma unroll
      for (int j = 0; j < 4; ++j) { const v2u* xr = (const v2u*)(H2 + (size_t)(r0 + w * 4 + j) * DM) + lane;
#pragma unroll
          for (int q = 0; q < 8; ++q) tb[j][q] = xr[64 * q]; }
      const f32x4* gr = (const f32x4*)g3 + lane; f32x4 g8[8];
#pragma unroll
      for (int q = 0; q < 8; ++q) g8[q] = gr[64 * q];
#pragma unroll
      for (int j = 0; j < 4; ++j) { const int row = r0 + w * 4 + j; f32x4 v[8]; float s = 0.f;
#pragma unroll
          for (int q = 0; q < 8; ++q) { v[q] = (f32x4){bf2f(tb[j][q].x & 0xffffu), bf2f(tb[j][q].x >> 16), bf2f(tb[j][q].y & 0xffffu), bf2f(tb[j][q].y >> 16)}; s += (v[q].x * v[q].x + v[q].y * v[q].y) + (v[q].z * v[q].z + v[q].w * v[q].w); }
          const float rstd = rsqrtf(wave_sum(s) * (1.f / DM) + EPS);
          if (lane == 0) rs[w * 4 + j] = rstd;
          unsigned* o4 = (unsigned*)(A3F + (size_t)row * DM) + lane;
#pragma unroll
          for (int q = 0; q < 8; ++q) { const f32x4 gg = g8[q]; o4[64 * q] = pk4_fp8(v[q].x * rstd * gg.x, v[q].y * rstd * gg.y, v[q].z * rstd * gg.z, v[q].w * rstd * gg.w); } } }
    { const int rt = w & 1, kq = w >> 1, ar = lane & 15, kg = lane >> 4; const float* WRT = WSP(float, WS_WRT);
      f32x4 a0 = {0.f, 0.f, 0.f, 0.f}, a1 = a0, a2 = a0;
      const bf16* hp = H2 + (size_t)(r0 + rt * 16 + ar) * DM + kq * 512 + kg * 4; const float* wp = WRT + (size_t)ar * DM + kq * 512 + kg * 4;
      for (int s0 = 0; s0 < 32; s0 += 8) {
          v2u ab[8]; f32x4 b0[8], b1[8], b2[8];
#pragma unroll
          for (int s = 0; s < 8; ++s) { ab[s] = *(const v2u*)(hp + (s0 + s) * 16); b0[s] = *(const f32x4*)(wp + (s0 + s) * 16); b1[s] = *(const f32x4*)(wp + 16 * DM + (s0 + s) * 16); b2[s] = *(const f32x4*)(wp + 32 * DM + (s0 + s) * 16); }
          __builtin_amdgcn_sched_barrier(0);
#pragma unroll
          for (int s = 0; s < 8; ++s) { const f32x4 a4 = {bf2f(ab[s].x & 0xffffu), bf2f(ab[s].x >> 16), bf2f(ab[s].y & 0xffffu), bf2f(ab[s].y >> 16)};
#pragma unroll
              for (int i = 0; i < 4; ++i) { a0 = __builtin_amdgcn_mfma_f32_16x16x4f32(a4[i], b0[s][i], a0, 0, 0, 0); a1 = __builtin_amdgcn_mfma_f32_16x16x4f32(a4[i], b1[s][i], a1, 0, 0, 0); a2 = __builtin_amdgcn_mfma_f32_16x16x4f32(a4[i], b2[s][i], a2, 0, 0, 0); } } }
#pragma unroll
      for (int rg = 0; rg < 4; ++rg) { LAS float* pr = part + (kq * 32 + rt * 16 + 4 * kg + rg) * 48 + ar; pr[0] = a0[rg]; pr[16] = a1[rg]; pr[32] = a2[rg]; } }
    LDS_WAIT(); __syncthreads();
    LAS float* lgL = part + 4 * 32 * 48;
    for (int idx = C.tid; idx < 32 * 48; idx += 512) { const int t = idx / 48, c = idx % 48;
        lgL[idx] = ((part[(0 * 32 + t) * 48 + c] + part[(1 * 32 + t) * 48 + c]) + (part[(2 * 32 + t) * 48 + c] + part[(3 * 32 + t) * 48 + c])) * rs[t]; }
    LDS_WAIT(); __syncthreads();
    if (C.tid < 32) { const int t = C.tid, row = r0 + t; const LAS float* lg = lgL + t * 48;
        const float* brg = C.p.in[I_BRG]; const float* bre = C.p.in[I_BRE];
        int grp = 0; float gm = -3.0e38f;
        for (int g = 0; g < 4; ++g) { const float x = lg[32 + g] + brg[g]; if (x > gm) { gm = x; grp = g; } }
        float gs = 0.f; for (int g = 0; g < 4; ++g) gs += __expf(lg[32 + g] + brg[g] - gm);
        const float pg = 1.f / gs;
        float v1 = -3.0e38f, v2 = -3.0e38f; int i1 = 0, i2 = 0;
        const f32x4 be0 = *(const f32x4*)(bre + grp * 8), be1 = *(const f32x4*)(bre + grp * 8 + 4); const float be[8] = {be0[0], be0[1], be0[2], be0[3], be1[0], be1[1], be1[2], be1[3]};
#pragma unroll
        for (int j = 0; j < 8; ++j) { const float x = lg[grp * 8 + j] + be[j];
            if (x > v1) { v2 = v1; i2 = i1; v1 = x; i1 = j; } else if (x > v2) { v2 = x; i2 = j; } }
        const float e2 = __expf(v2 - v1); const float w1 = pg / (1.f + e2), w2 = pg * e2 / (1.f + e2);
        unsigned* cnt = WSP(unsigned, WS_CTL) + CW_CNT; int* list = WSP(int, WS_LIST); float* gw = WSP(float, WS_GATEW);
        const int ea = grp * 8 + i1, eb = grp * 8 + i2;
        LAS unsigned* lc = (LAS unsigned*)(lgL + 32 * 48);
        lc[t] = 0u; LDS_WAIT();
        const unsigned la = __hip_atomic_fetch_add((LAS unsigned*)(lc + ea), 1u, __ATOMIC_RELAXED, __HIP_MEMORY_SCOPE_WORKGROUP);
        const unsigned lb = __hip_atomic_fetch_add((LAS unsigned*)(lc + eb), 1u, __ATOMIC_RELAXED, __HIP_MEMORY_SCOPE_WORKGROUP);
        LDS_WAIT();
        const unsigned mine = lc[t]; unsigned base = 0u; if (mine) base = atomicAdd(cnt + t * 64, mine);
        lc[32 + t] = base; LDS_WAIT();
        const unsigned pa = lc[32 + ea] + la, pb = lc[32 + eb] + lb;
        list[ea * 8192 + pa] = row * 2; gw[row * 2] = w1; list[eb * 8192 + pb] = row * 2 + 1; gw[row * 2 + 1] = w2; }
}

__device__ __forceinline__ void final_phase(const Ctx& C) {
    const int lane = C.lane; const bf16* H2 = WSP(bf16, WS_H1B); const unsigned char* Y = WSP(unsigned char, WS_Y); const float* gw = WSP(float, WS_GATEW); const float* gf = C.p.in[I_NFING];
    f32x4 g8[8];
#pragma unroll
    for (int q = 0; q < 8; ++q) g8[q] = ((const f32x4*)gf + lane)[64 * q];
    for (int j = 0; j < 4; ++j) { const int row = blockIdx.x * 32 + C.wave * 4 + j; const float w0 = gw[row * 2], w1 = gw[row * 2 + 1];
        const v2u* xr = (const v2u*)(H2 + (size_t)row * DM) + lane; const unsigned* y0 = (const unsigned*)(Y + (size_t)(row * 2) * DM) + lane; const unsigned* y1 = (const unsigned*)(Y + (size_t)(row * 2 + 1) * DM) + lane;
        f32x4 v[8]; float s = 0.f;
#pragma unroll
        for (int q = 0; q < 8; ++q) { const unsigned a = __builtin_nontemporal_load(y0 + 64 * q), b = __builtin_nontemporal_load(y1 + 64 * q); const v2u tb = __builtin_nontemporal_load(xr + 64 * q); f32x4 x = {bf2f(tb.x & 0xffffu), bf2f(tb.x >> 16), bf2f(tb.y & 0xffffu), bf2f(tb.y >> 16)};
            const f32x2 a01 = __builtin_amdgcn_cvt_pk_f32_fp8((int)a, false), a23 = __builtin_amdgcn_cvt_pk_f32_fp8((int)a, true), b01 = __builtin_amdgcn_cvt_pk_f32_fp8((int)b, false), b23 = __builtin_amdgcn_cvt_pk_f32_fp8((int)b, true);
            x.x += w0 * a01[0] + w1 * b01[0]; x.y += w0 * a01[1] + w1 * b01[1]; x.z += w0 * a23[0] + w1 * b23[0]; x.w += w0 * a23[1] + w1 * b23[1];
            v[q] = x; s += (x.x * x.x + x.y * x.y) + (x.z * x.z + x.w * x.w); }
        const float rstd = rsqrtf(wave_sum(s) * (1.f / DM) + EPS);
        f32x4* o = (f32x4*)(C.p.out + (size_t)row * DM) + lane;
#pragma unroll
        for (int q = 0; q < 8; ++q) __builtin_nontemporal_store(v[q] * rstd * g8[q], o + 64 * q); }
}

constexpr int N_PHASES = 12;
__global__ void __launch_bounds__(512, 2) mk_fwd(Params p) {
    extern __shared__ __attribute__((aligned(16))) unsigned char lds_raw[];
    Ctx C; C.p = p; C.lds = (LAS unsigned char*)lds_raw; C.tid = threadIdx.x; C.lane = C.tid & 63; C.wave = __builtin_amdgcn_readfirstlane(C.tid >> 6);
    C.G = gridDim.x; { const int bx = blockIdx.x; C.vcu = (C.G % 8 == 0) ? (bx % 8) * (C.G / 8) + bx / 8 : bx; }
    volatile LAS unsigned* MISC = (volatile LAS unsigned*)(C.lds + MISC_OFF);
    const int lo = p.ph_lo, hi = p.ph_hi;
    const bool multi = (hi - lo) > 1;
    XcdBarrier bar; bar.bar = WSP(unsigned, WS_CTL) + CW_BAR; bar.x = 0; bar.st = MISC;
    if (C.tid < 64) MISC[C.tid] = 0u;
    __syncthreads();
    if (multi) bar = xcd_barrier_post(WSP(unsigned, WS_CTL) + CW_BAR, MISC);
#define PHASE_BEGIN(k) if (lo <= (k) && (k) < hi) { { int t_ = threadIdx.x; asm volatile("" : "+v"(t_)); C.tid = t_; C.lane = t_ & 63; C.wave = __builtin_amdgcn_readfirstlane(t_ >> 6); \
        }
#define PHASE_END(k) if ((k) + 1 < hi) { if ((k) < 8) xcd_barrier_work(bar, C); else xcd_barrier(bar); } }
#define GEMM_PHASE(kind) gemm_phase_fast<kind>(C)
    PHASE_BEGIN(0) p0_prologue(C); PHASE_END(0)
    PHASE_BEGIN(1) GEMM_PHASE(GK_PROJ); PHASE_END(1)
    PHASE_BEGIN(2) queue_deadline(C); la2_phase_a(C); PHASE_END(2)
    PHASE_BEGIN(3) la_phase_scan(C); GEMM_PHASE(GK_XPRE); PHASE_END(3)
    PHASE_BEGIN(4) la2_phase_c(C); PHASE_END(4)
    PHASE_BEGIN(5) GEMM_PHASE(GK_OUT); PHASE_END(5)
    PHASE_BEGIN(6) GEMM_PHASE(GK_SCORE); PHASE_END(6)
    PHASE_BEGIN(7) GEMM_PHASE(GK_PV); PHASE_END(7)
    PHASE_BEGIN(8) router_phase(C); __syncthreads(); queue_drain(C); PHASE_END(8)
    PHASE_BEGIN(9) GEMM_PHASE(GK_MOE1); GEMM_PHASE(GK_MOE2); PHASE_END(9)
    PHASE_BEGIN(11) final_phase(C); PHASE_END(11)
}

extern "C" void kernel_launch(void* const* d_in, const int* in_sizes, int n_in, void* d_out, int out_size, void* d_ws, size_t ws_size, hipStream_t stream) {
    static int grid = 0;
    if (grid == 0) {
        if (n_in != 24 || out_size != MTOK * DM || ws_size < WS_END) { fprintf(stderr, "kernel_launch: unexpected shapes (n_in %d out %d ws %zu need %zu)\n", n_in, out_size, ws_size, (size_t)WS_END); grid = -1; return; }
        if (hipFuncSetAttribute((const void*)mk_fwd, hipFuncAttributeMaxDynamicSharedMemorySize, LDS_BYTES) != hipSuccess) { fprintf(stderr, "kernel_launch: hipFuncSetAttribute failed\n"); grid = -1; return; }
        int dev = 0, cus = 0; (void)hipGetDevice(&dev); (void)hipDeviceGetAttribute(&cus, hipDeviceAttributeMultiprocessorCount, dev);
        int per_cu = 0; (void)hipOccupancyMaxActiveBlocksPerMultiprocessor(&per_cu, (const void*)mk_fwd, 512, LDS_BYTES); (void)hipGetLastError();
        if (cus != 256 || per_cu < 1) fprintf(stderr, "kernel_launch: note: cus %d per_cu %d\n", cus, per_cu);
        grid = 256;
    }
    if (grid < 0) return;
    (void)hipMemsetAsync((char*)d_ws + WS_CTL, 0, CTL_ZERO_BYTES, stream);
    Params a{};
    for (int i = 0; i < 24; ++i) a.in[i] = (const float*)d_in[i];
    a.out = (float*)d_out; a.ws = (unsigned char*)d_ws;
#if MK_ONE_LAUNCH
    a.ph_lo = 0; a.ph_hi = N_PHASES;
    hipLaunchKernelGGL(mk_fwd, dim3(grid), dim3(512), LDS_BYTES, stream, a);
#else
    for (int ph = 0; ph < N_PHASES; ++ph) { a.ph_lo = ph; a.ph_hi = ph + 1; hipLaunchKernelGGL(mk_fwd, dim3(grid), dim3(512), LDS_BYTES, stream, a); }
#endif
}
```
